# Optimizing an MI355X kernel written in HIP

```python
import math
import jax, jax.numpy as jnp
from jax import lax
import numpy as np

D_MODEL = 1024
BATCH = 8
SEQ = 4096
DEPTH = 2
DEC_BATCH = 1
DEC_SEQ = 16384
PAST_LEN = 128

HEAD_DIM = 64
N_Q_HEADS = 8
N_KV_HEADS = 2
GQA_GROUP = N_Q_HEADS // N_KV_HEADS
D_ATTN = N_Q_HEADS * HEAD_DIM
D_KV = N_KV_HEADS * HEAD_DIM
WINDOW = 128
BLOCK = 128
POOL_WINDOWS = (2, 4, 8, 16)
N_POOL_GROUPS = len(POOL_WINDOWS)
D_POOL = 256
POOL_GROUP_DIM = D_POOL // N_POOL_GROUPS
D_HYENA = 256
HYENA_ORDER = 2
FILTER_BANDS = 16
FILTER_EMB = 1 + 2 * FILTER_BANDS
FILTER_HIDDEN = 64
N_FILTERS = 2 * HYENA_ORDER
DECAY_FAST_PCT = 0.3
DECAY_SLOW_PCT = 1.5
DECAY_TARGET = 1e-2
SHORT_CONV = 3
D_IN_PROJ = D_ATTN + 2 * D_KV + D_POOL + (HYENA_ORDER + 1) * D_HYENA
D_CAT = D_ATTN + D_POOL + D_HYENA
D_FF = 2816
FFN_CONV = 3
EPS = 1e-6
NEG_INF = -1e30

kernel_name = "hymba_style_bidir_hybrid_encoder"


def rms_norm(x, g):
    xf = x.astype(jnp.float32)
    y = xf * lax.rsqrt(jnp.mean(xf * xf, axis=-1, keepdims=True) + EPS) * g.astype(jnp.float32)
    return y.astype(x.dtype)


def dwconv3(x, w, b):
    xp = jnp.pad(x, ((0, 0), (1, 1), (0, 0)))
    return xp[:, :-2] * w[0] + xp[:, 1:-1] * w[1] + xp[:, 2:] * w[2] + b


def alibi_slopes():
    h = jnp.arange(N_Q_HEADS, dtype=jnp.float32)
    return 2.0 ** (-8.0 * (h + 1.0) / N_Q_HEADS)


def windowed_attention(q, k, v, q_norm_g, k_norm_g, sink):
    B, L = q.shape[0], q.shape[1]
    nb = L // BLOCK
    q = rms_norm(q.reshape(B, L, N_Q_HEADS, HEAD_DIM), q_norm_g)
    k = rms_norm(k.reshape(B, L, N_KV_HEADS, HEAD_DIM), k_norm_g)
    v = v.reshape(B, L, N_KV_HEADS, HEAD_DIM)
    pad = ((0, 0), (BLOCK, BLOCK), (0, 0), (0, 0))
    kp = jnp.pad(k, pad).reshape(B, nb + 2, BLOCK, N_KV_HEADS, HEAD_DIM)
    vp = jnp.pad(v, pad).reshape(B, nb + 2, BLOCK, N_KV_HEADS, HEAD_DIM)
    kb = jnp.concatenate([kp[:, :-2], kp[:, 1:-1], kp[:, 2:]], axis=2)
    vb = jnp.concatenate([vp[:, :-2], vp[:, 1:-1], vp[:, 2:]], axis=2)
    qb = q.reshape(B, nb, BLOCK, N_KV_HEADS, GQA_GROUP, HEAD_DIM)
    scale = 1.0 / math.sqrt(HEAD_DIM)
    s = jnp.einsum('bnqkgd,bnskd->bnkgqs', qb, kb, preferred_element_type=jnp.float32) * scale
    blk = jnp.arange(nb)[:, None]
    qpos = blk * BLOCK + jnp.arange(BLOCK)[None, :]
    kpos = (blk - 1) * BLOCK + jnp.arange(3 * BLOCK)[None, :]
    dist = jnp.abs(qpos[:, :, None] - kpos[:, None, :])
    valid = (dist <= WINDOW) & (kpos[:, None, :] >= 0) & (kpos[:, None, :] < L)
    slopes = alibi_slopes().reshape(N_KV_HEADS, GQA_GROUP)
    s = s - slopes[None, None, :, :, None, None] * dist.astype(jnp.float32)[None, :, None, None, :, :]
    s = jnp.where(valid[None, :, None, None, :, :], s, NEG_INF)
    sink_col = jnp.broadcast_to(sink.astype(jnp.float32).reshape(1, 1, N_KV_HEADS, GQA_GROUP, 1, 1),
                                s.shape[:-1] + (1,))
    p = jax.nn.softmax(jnp.concatenate([s, sink_col], axis=-1), axis=-1)[..., :-1]
    o = jnp.einsum('bnkgqs,bnskd->bnqkgd', p.astype(v.dtype), vb)
    return o.reshape(B, L, D_ATTN)


def multiscale_pool(u, pool_w, pool_scale):
    B, L, _ = u.shape
    uf = u.astype(jnp.float32)
    cs = jnp.concatenate([jnp.zeros((B, 1, D_POOL), jnp.float32), jnp.cumsum(uf, axis=1)], axis=1)
    t = jnp.arange(L)
    outs = []
    for gi, w in enumerate(POOL_WINDOWS):
        sl = slice(gi * POOL_GROUP_DIM, (gi + 1) * POOL_GROUP_DIM)
        lo = jnp.clip(t - w // 2, 0, L)
        hi = jnp.clip(t - w // 2 + w, 0, L)
        csg = cs[:, :, sl]
        mean = (jnp.take(csg, hi, axis=1) - jnp.take(csg, lo, axis=1)) / (hi - lo).astype(jnp.float32)[None, :, None]
        d = mean - uf[:, :, sl]
        outs.append(d @ pool_w[gi].astype(jnp.float32))
    y = jnp.concatenate(outs, axis=-1) * pool_scale.astype(jnp.float32)
    return y.astype(u.dtype)


def hyena_filters(L, w1, b1, freq1, w2, b2, freq2, w3):
    t_norm = jnp.linspace(0.0, 1.0, L, dtype=jnp.float32)[:, None]
    n = jnp.arange(L, dtype=jnp.float32)[:, None]
    bands = jnp.linspace(1e-4, FILTER_BANDS - 1, FILTER_BANDS, dtype=jnp.float32)[None, :]
    ang = 2.0 * math.pi * n * bands / L
    z = jnp.concatenate([t_norm, jnp.cos(ang), -jnp.sin(ang)], axis=-1)
    f32 = jnp.float32
    h = jnp.sin(freq1.astype(f32) * (z @ w1.astype(f32) + b1.astype(f32)))
    h = jnp.sin(freq2.astype(f32) * (h @ w2.astype(f32) + b2.astype(f32)))
    h = (h @ w3.astype(f32)).reshape(L, N_FILTERS, D_HYENA)
    max_decay = math.log(DECAY_TARGET) / DECAY_FAST_PCT
    min_decay = math.log(DECAY_TARGET) / DECAY_SLOW_PCT
    deltas = jnp.abs(jnp.linspace(min_decay, max_decay, D_HYENA, dtype=jnp.float32))
    decay = jnp.exp(-t_norm[:, :, None] * deltas[None, None, :])
    return h * decay


def bidir_fftconv(u, h_fwd, h_bwd, bias):
    L = u.shape[1]
    C = u.shape[2]
    k = jnp.concatenate([h_fwd, jnp.zeros((1, C), jnp.float32), h_bwd[1:][::-1]], axis=0)
    K = jnp.fft.rfft(k, axis=0)
    uf = u.astype(jnp.float32)
    U = jnp.fft.rfft(uf, n=2 * L, axis=1)
    y = jnp.fft.irfft(U * K[None], n=2 * L, axis=1)[:, :L]
    return (y + bias.astype(jnp.float32) * uf).astype(u.dtype)


def hyena_mixer(u, conv_w, conv_b, filters, hy_bias):
    u = dwconv3(u, conv_w, conv_b)
    v = u[..., :D_HYENA]
    gates = (u[..., D_HYENA:2 * D_HYENA], u[..., 2 * D_HYENA:])
    z = v
    for o in range(HYENA_ORDER):
        z = gates[o] * bidir_fftconv(z, filters[:, 2 * o], filters[:, 2 * o + 1], hy_bias[o])
    return z


def encoder_layer(x, norm1_g, w_in, q_norm_g, k_norm_g, attn_sink, pool_w, pool_scale,
                  hy_conv_w, hy_conv_b, filt_w1, filt_b1, filt_freq1, filt_w2, filt_b2, filt_freq2,
                  filt_w3, hy_bias, out_norm_g, w_out, norm2_g, w_ffn_in, ffn_conv_w, ffn_conv_b, w_ffn_out):
    L = x.shape[1]
    h = rms_norm(x, norm1_g)
    p = h @ w_in
    o0 = D_ATTN
    o1 = o0 + D_KV
    o2 = o1 + D_KV
    o3 = o2 + D_POOL
    q, k, v = p[..., :o0], p[..., o0:o1], p[..., o1:o2]
    pool_in, hy_in = p[..., o2:o3], p[..., o3:]
    a = windowed_attention(q, k, v, q_norm_g, k_norm_g, attn_sink)
    b = multiscale_pool(pool_in, pool_w, pool_scale)
    filters = hyena_filters(L, filt_w1, filt_b1, filt_freq1, filt_w2, filt_b2, filt_freq2, filt_w3)
    c = hyena_mixer(hy_in, hy_conv_w, hy_conv_b, filters, hy_bias)
    cat = jnp.concatenate([rms_norm(a, out_norm_g[:D_ATTN]),
                           rms_norm(b, out_norm_g[D_ATTN:D_ATTN + D_POOL]),
                           rms_norm(c, out_norm_g[D_ATTN + D_POOL:])], axis=-1)
    x = x + cat @ w_out
    h = rms_norm(x, norm2_g)
    u = dwconv3(h @ w_ffn_in, ffn_conv_w, ffn_conv_b)
    act = jax.nn.gelu(u[..., :D_FF], approximate=False) * u[..., D_FF:]
    return x + act @ w_ffn_out


def run_trunk(x, norm1_g, w_in, q_norm_g, k_norm_g, attn_sink, pool_w, pool_scale,
              hy_conv_w, hy_conv_b, filt_w1, filt_b1, filt_freq1, filt_w2, filt_b2, filt_freq2,
              filt_w3, hy_bias, out_norm_g, w_out, norm2_g, w_ffn_in, ffn_conv_w, ffn_conv_b, w_ffn_out):
    for l in range(DEPTH):
        x = encoder_layer(x, norm1_g[l], w_in[l], q_norm_g[l], k_norm_g[l], attn_sink[l], pool_w[l],
                          pool_scale[l], hy_conv_w[l], hy_conv_b[l], filt_w1[l], filt_b1[l], filt_freq1[l],
                          filt_w2[l], filt_b2[l], filt_freq2[l], filt_w3[l], hy_bias[l], out_norm_g[l],
                          w_out[l], norm2_g[l], w_ffn_in[l], ffn_conv_w[l], ffn_conv_b[l], w_ffn_out[l])
    return x


def setup_inputs(seed: int = 0) -> dict:
    key = jax.random.key(seed)
    ks = jax.random.split(key, 32)
    f32 = jnp.float32

    def nrm(k, shape, scale):
        return jax.random.normal(k, shape, f32) * scale

    return {
        "x_prompt": nrm(ks[0], (BATCH, SEQ, D_MODEL), 1.0),
        "x_sample": nrm(ks[1], (DEC_BATCH, DEC_SEQ, D_MODEL), 1.0),
        "norm1_g": 1.0 + nrm(ks[2], (DEPTH, D_MODEL), 0.05),
        "w_in": nrm(ks[3], (DEPTH, D_MODEL, D_IN_PROJ), D_MODEL ** -0.5),
        "q_norm_g": 1.0 + nrm(ks[4], (DEPTH, HEAD_DIM), 0.05),
        "k_norm_g": 1.0 + nrm(ks[5], (DEPTH, HEAD_DIM), 0.05),
        "attn_sink": nrm(ks[6], (DEPTH, N_Q_HEADS), 0.5),
        "pool_w": nrm(ks[7], (DEPTH, N_POOL_GROUPS, POOL_GROUP_DIM, POOL_GROUP_DIM), POOL_GROUP_DIM ** -0.5),
        "pool_scale": 1.0 + nrm(ks[8], (DEPTH, D_POOL), 0.1),
        "hy_conv_w": nrm(ks[9], (DEPTH, SHORT_CONV, (HYENA_ORDER + 1) * D_HYENA), SHORT_CONV ** -0.5),
        "hy_conv_b": nrm(ks[10], (DEPTH, (HYENA_ORDER + 1) * D_HYENA), 0.02),
        "filt_w1": nrm(ks[11], (DEPTH, FILTER_EMB, FILTER_HIDDEN), FILTER_EMB ** -0.5),
        "filt_b1": nrm(ks[12], (DEPTH, FILTER_HIDDEN), 0.02),
        "filt_freq1": 1.0 + nrm(ks[13], (DEPTH, FILTER_HIDDEN), 0.1),
        "filt_w2": nrm(ks[14], (DEPTH, FILTER_HIDDEN, FILTER_HIDDEN), FILTER_HIDDEN ** -0.5),
        "filt_b2": nrm(ks[15], (DEPTH, FILTER_HIDDEN), 0.02),
        "filt_freq2": 1.0 + nrm(ks[16], (DEPTH, FILTER_HIDDEN), 0.1),
        "filt_w3": nrm(ks[17], (DEPTH, FILTER_HIDDEN, N_FILTERS * D_HYENA), 0.05 * FILTER_HIDDEN ** -0.5),
        "hy_bias": nrm(ks[18], (DEPTH, HYENA_ORDER, D_HYENA), 0.1),
        "out_norm_g": 1.0 + nrm(ks[19], (DEPTH, D_CAT), 0.05),
        "w_out": nrm(ks[20], (DEPTH, D_CAT, D_MODEL), (2.0 * DEPTH * D_CAT) ** -0.5),
        "norm2_g": 1.0 + nrm(ks[21], (DEPTH, D_MODEL), 0.05),
        "w_ffn_in": nrm(ks[22], (DEPTH, D_MODEL, 2 * D_FF), D_MODEL ** -0.5),
        "ffn_conv_w": nrm(ks[23], (DEPTH, FFN_CONV, 2 * D_FF), FFN_CONV ** -0.5),
        "ffn_conv_b": nrm(ks[24], (DEPTH, 2 * D_FF), 0.02),
        "w_ffn_out": nrm(ks[25], (DEPTH, D_FF, D_MODEL), (2.0 * DEPTH * D_FF) ** -0.5),
    }


def reference(x_prompt, x_sample, norm1_g, w_in, q_norm_g, k_norm_g, attn_sink, pool_w, pool_scale,
              hy_conv_w, hy_conv_b, filt_w1, filt_b1, filt_freq1, filt_w2, filt_b2, filt_freq2,
              filt_w3, hy_bias, out_norm_g, w_out, norm2_g, w_ffn_in, ffn_conv_w, ffn_conv_b, w_ffn_out):
    y_prompt = run_trunk(x_prompt, norm1_g, w_in, q_norm_g, k_norm_g, attn_sink, pool_w, pool_scale,
                         hy_conv_w, hy_conv_b, filt_w1, filt_b1, filt_freq1, filt_w2, filt_b2, filt_freq2,
                         filt_w3, hy_bias, out_norm_g, w_out, norm2_g, w_ffn_in, ffn_conv_w, ffn_conv_b, w_ffn_out)
    y_sample = run_trunk(x_sample, norm1_g, w_in, q_norm_g, k_norm_g, attn_sink, pool_w, pool_scale,
                         hy_conv_w, hy_conv_b, filt_w1, filt_b1, filt_freq1, filt_w2, filt_b2, filt_freq2,
                         filt_w3, hy_bias, out_norm_g, w_out, norm2_g, w_ffn_in, ffn_conv_w, ffn_conv_b, w_ffn_out)
    return (y_prompt, y_sample)
```

```cpp
#include <hip/hip_runtime.h>
#include <hip/hip_cooperative_groups.h>
#include <cstdio>
#include <cstdint>
namespace cg = cooperative_groups;

#define DI __device__ __forceinline__
#define LAS __attribute__((address_space(3)))
typedef unsigned short bf16_t;
typedef short bf16x8 __attribute__((ext_vector_type(8)));
typedef float f32x4 __attribute__((ext_vector_type(4)));
typedef float f32x16 __attribute__((ext_vector_type(16)));
typedef float f32x2 __attribute__((ext_vector_type(2)));
typedef unsigned u32x4 __attribute__((ext_vector_type(4)));
typedef unsigned u32x2 __attribute__((ext_vector_type(2)));
typedef __bf16 bf16x2n __attribute__((ext_vector_type(2)));

constexpr int NT = 49152, NTP = 32768, DM = 1024, NIN = 1792, DFF = 2816, NFF2 = 5632;
constexpr int LDS_BYTES = 147456;
#ifndef PHM
#define PHM 0xFFFF
#endif
#ifndef REP_FFN
#define REP_FFN 1
#endif
#ifndef REP_HY
#define REP_HY 1
#endif
#ifndef REP_L1
#define REP_L1 1
#endif
#ifndef REP_L2
#define REP_L2 1
#endif
#ifndef REP_P0
#define REP_P0 1
#endif
constexpr float EPSV = 1e-6f;
constexpr float LOG2E = 1.4426950408889634f;

constexpr size_t WS_WIN = 0;
constexpr size_t WS_WOUT = WS_WIN + 2ull * 1792 * 1024 * 2;
constexpr size_t WS_WF1 = WS_WOUT + 2ull * 1024 * 1024 * 2;
constexpr size_t WS_WF2 = WS_WF1 + 2ull * 5632 * 1024 * 2;
constexpr size_t WS_HB = WS_WF2 + 2ull * 1024 * 2816 * 2;
constexpr int KRS_LEN = 2 * 16384 + 512, KRP_LEN = 2 * 4096 + 512, KR_PAD = 256;
constexpr size_t WS_KRS = WS_HB + (size_t)NT * 1024 * 2;
constexpr size_t WS_KRP = WS_KRS + 4ull * 256 * KRS_LEN * 2;
constexpr size_t WS_P = WS_KRP + 4ull * 256 * KRP_LEN * 2;
constexpr size_t WS_HY = WS_P + (size_t)NT * 1792 * 2;
constexpr size_t HY_ARR = (size_t)256 * NT;
constexpr size_t WS_ACT = WS_P;
constexpr size_t WS_BAR = WS_HY + 4 * HY_ARR * 2;
constexpr size_t WS_SS = WS_BAR + 16384;
constexpr size_t WS_END = WS_SS + 4ull * NT * 4;
static_assert(WS_ACT + (size_t)NT * 2816 * 2 <= WS_BAR, "act alias");

struct Params { const float* in[26]; float* out; unsigned char* ws; };
typedef const __attribute__((address_space(4))) Params* KP;

DI unsigned pk2(float lo, float hi) { f32x2 v = {lo, hi}; return __builtin_bit_cast(unsigned, __builtin_convertvector(v, bf16x2n)); }
DI float bflo(unsigned u) { return __uint_as_float(u << 16); }
DI float bfhi(unsigned u) { return __uint_as_float(u & 0xffff0000u); }
DI float bf2f(bf16_t v) { return __uint_as_float(((unsigned)v) << 16); }
DI bf16_t f2bf(float x) { return (bf16_t)(pk2(x, 0.f) & 0xffffu); }
DI void unpack8(const u32x4& r, float (&f)[8]) {
    f[0] = bflo(r.x); f[1] = bfhi(r.x); f[2] = bflo(r.y); f[3] = bfhi(r.y); f[4] = bflo(r.z); f[5] = bfhi(r.z); f[6] = bflo(r.w); f[7] = bfhi(r.w);
}
DI u32x4 pack8(const float (&f)[8]) { u32x4 w; w.x = pk2(f[0], f[1]); w.y = pk2(f[2], f[3]); w.z = pk2(f[4], f[5]); w.w = pk2(f[6], f[7]); return w; }
DI void seq_info(int tok, int& s0, int& L) { if (tok < NTP) { s0 = tok & ~4095; L = 4096; } else { s0 = NTP; L = 16384; } }
DI float wave_sum(float v) {
#pragma unroll
    for (int o = 1; o < 64; o <<= 1) v += __shfl_xor(v, o);
    return v;
}
DI float sin_rev(float rev) { return __builtin_amdgcn_sinf(__builtin_amdgcn_fractf(rev)); }
DI float cos_rev(float rev) { return __builtin_amdgcn_cosf(__builtin_amdgcn_fractf(rev)); }
DI float sin_rad(float x) { return sin_rev(x * 0.15915494309189535f); }
DI int opaque_v(int x) { asm volatile("" : "+v"(x)); return x; }
DI int opaque_s(int x) { asm volatile("" : "+s"(x)); return x; }
DI float gelu_f(float v) {
    const float av = fabsf(v), t = __builtin_amdgcn_rcpf(av * 0.2316418882f + 1.0f);
    float q = t * 0.5307027145f + (-0.7265760135f); q = q * t + 0.7107068705f; q = q * t + (-0.142248368f); q = q * t + 0.127414796f; q = q * t;
    const float e = __builtin_amdgcn_exp2f((v * v) * (-0.72134752044f));
    const float m = v * (q * e);
    return v < 0.f ? m : v - m;
}
DI int crow(int reg, int h) { return (reg & 3) + 8 * (reg >> 2) + 4 * h; }

namespace pg8 {
constexpr int BM = 256, BK = 64, HALF = 128, HTB = HALF * BK * 2, NXCD = 8, WGM = 8;
DI int lds_byte(int r, int c) { const int st = (r >> 4) * 2 + (c >> 5), rr = r & 15, cc = c & 31, ob = rr * 64 + cc * 2; return st * 1024 + (ob ^ (((ob >> 9) & 1) << 5)); }
DI void stage_rc(int b, int& R, int& C) { const int st = b / 1024, sb = b % 1024, swz = sb ^ (((sb >> 9) & 1) << 5); R = (st >> 1) * 16 + swz / 64; C = (st & 1) * 32 + (swz % 64) / 2; }
DI int perm32(int rho) { const int n = rho >> 4, i = rho & 15; return 8 * (i >> 2) + 4 * n + (i & 3); }

struct Unit { int pm, pn, arow; };
struct Gemm { const bf16_t* A; const bf16_t* Bt; int K; };

struct StaticOrder {
    int nM, nN, nwg, G, c;
    DI void init(int M, int N, int G_, int c_) { nM = M / BM; nN = N / BM; nwg = nM * nN; G = G_; c = c_; }
    DI bool next(int i, Unit& u) const {
        const long Lx = (long)i * G + c; if (Lx >= nwg) return false;
        int wgid = (int)Lx; { const int q = nwg / NXCD, r = nwg % NXCD, xcd = wgid % NXCD, off = wgid / NXCD; wgid = (xcd < r ? xcd * (q + 1) : r * (q + 1) + (xcd - r) * q) + off; }
        const int nig = WGM * nN, gid = wgid / nig, fm = gid * WGM, gsz = (nM - fm) < WGM ? (nM - fm) : WGM;
        u.pm = fm + ((wgid % nig) % gsz); u.pn = (wgid % nig) / gsz; u.arow = u.pm * BM; return true;
    }
};
struct OneUnit {
    Unit u;
    DI bool next(int i, Unit& o) const { if (i != 0) return false; o = u; return true; }
};

struct EpiBf16 {
    static constexpr bool AFTER_DRAIN = false, PREFETCH = false;
    bf16_t* O; int ldc; const float* ss;
    DI void operator()(const f32x4 (&acc)[2][2][4][2], const Unit& u, int wr, int wc, int fr, int fq) const {
        const int row0 = u.pm * BM + wr * 64 + fr, col0 = u.pn * BM + wc * 32 + 8 * fq;
#pragma unroll
        for (int ai = 0; ai < 2; ++ai)
#pragma unroll
            for (int m = 0; m < 4; ++m) {
                const int row = row0 + ai * HALF + m * 16;
                const float rs = rsqrtf(ss[row] * (1.0f / 1024.0f) + EPSV);
                bf16_t* rowp = O + (size_t)row * ldc + col0;
#pragma unroll
                for (int bj = 0; bj < 2; ++bj) {
                    const f32x4 v0 = acc[ai][bj][m][0] * rs, v1 = acc[ai][bj][m][1] * rs;
                    u32x4 w; w.x = pk2(v0[0], v0[1]); w.y = pk2(v0[2], v0[3]); w.z = pk2(v1[0], v1[1]); w.w = pk2(v1[2], v1[3]);
                    *(u32x4*)(rowp + bj * HALF) = w;
                }
            }
    }
    DI void fused(const f32x4 (&)[2][2][4][2], const Unit&, int, int, int, int, LAS unsigned char*, int) const {}
};
template <bool FINAL>
struct EpiResid {
    static constexpr bool AFTER_DRAIN = false, PREFETCH = false;
    bf16_t* XB; float* ss; float* out;
    DI void operator()(const f32x4 (&acc)[2][2][4][2], const Unit& u, int wr, int wc, int fr, int fq) const {
        const int row0 = u.pm * BM + wr * 64 + fr, col0 = u.pn * BM + wc * 32 + 8 * fq;
#pragma unroll
        for (int ai = 0; ai < 2; ++ai)
#pragma unroll
            for (int m = 0; m < 4; ++m) {
                const int row = row0 + ai * HALF + m * 16;
                bf16_t* xp = XB + (size_t)row * DM + col0;
                float sq = 0.f;
#pragma unroll
                for (int bj = 0; bj < 2; ++bj) {
                    const u32x4 r = *(const u32x4*)(xp + bj * HALF);
                    float f[8]; unpack8(r, f);
                    const f32x4 a0 = acc[ai][bj][m][0], a1 = acc[ai][bj][m][1];
                    f[0] += a0[0]; f[1] += a0[1]; f[2] += a0[2]; f[3] += a0[3]; f[4] += a1[0]; f[5] += a1[1]; f[6] += a1[2]; f[7] += a1[3];
                    if (FINAL) {
                        float* op = out + (size_t)row * DM + col0 + bj * HALF;
                        *(f32x4*)op = (f32x4){f[0], f[1], f[2], f[3]}; *(f32x4*)(op + 4) = (f32x4){f[4], f[5], f[6], f[7]};
                    } else {
#pragma unroll
                        for (int j = 0; j < 8; ++j) sq += f[j] * f[j];
                        *(u32x4*)(xp + bj * HALF) = pack8(f);
                    }
                }
                if (!FINAL) {
                    sq += __shfl_xor(sq, 16); sq += __shfl_xor(sq, 32);
                    if (fq == 0) atomicAdd(ss + row, sq);
                }
            }
    }
    DI void fused(const f32x4 (&)[2][2][4][2], const Unit&, int, int, int, int, LAS unsigned char*, int) const {}
};
struct EpiFfn {
    static constexpr bool AFTER_DRAIN = true, PREFETCH = false;
    bf16_t* act; const float* cw; const float* cb; int tok0, jlo, jhi;
    DI void operator()(const f32x4 (&)[2][2][4][2], const Unit&, int, int, int, int) const {}
    DI void fused(const f32x4 (&acc)[2][2][4][2], const Unit& u, int wr, int wc, int fr, int fq, LAS unsigned char* lds, int tid) const {
        constexpr int TS = 528;
#pragma unroll
        for (int ai = 0; ai < 2; ++ai)
#pragma unroll
            for (int m = 0; m < 4; ++m) {
                const int row = ai * HALF + wr * 64 + m * 16 + fr;
#pragma unroll
                for (int bj = 0; bj < 2; ++bj) {
                    const f32x4 v0 = acc[ai][bj][m][0], v1 = acc[ai][bj][m][1];
                    u32x4 w; w.x = pk2(v0[0], v0[1]); w.y = pk2(v0[2], v0[3]); w.z = pk2(v1[0], v1[1]); w.w = pk2(v1[2], v1[3]);
                    *(LAS u32x4*)(lds + row * TS + (bj * HALF + wc * 32 + 8 * fq) * 2) = w;
                }
            }
        __syncthreads();
        const int c8 = (tid & 15) * 8, rg = tid >> 4;
        const int gcol = u.pn * 128 + c8, ucol = DFF + gcol;
        float wg[3][8], wu[3][8], bg[8], bu[8];
#pragma unroll
        for (int k = 0; k < 3; ++k)
#pragma unroll
            for (int j = 0; j < 8; ++j) { wg[k][j] = cw[k * NFF2 + gcol + j]; wu[k][j] = cw[k * NFF2 + ucol + j]; }
#pragma unroll
        for (int j = 0; j < 8; ++j) { bg[j] = cb[gcol + j]; bu[j] = cb[ucol + j]; }
        float pg[8], pu[8], cg_[8], cu[8], ng[8], nu[8];
        const int r0 = rg * 8;
        {
            u32x4 a = {0, 0, 0, 0}, b = {0, 0, 0, 0};
            if (r0 > 0) { a = *(const LAS u32x4*)(lds + (r0 - 1) * TS + c8 * 2); b = *(const LAS u32x4*)(lds + (r0 - 1) * TS + (128 + c8) * 2); }
            unpack8(a, pg); unpack8(b, pu);
            a = *(const LAS u32x4*)(lds + r0 * TS + c8 * 2); b = *(const LAS u32x4*)(lds + r0 * TS + (128 + c8) * 2);
            unpack8(a, cg_); unpack8(b, cu);
        }
#pragma unroll
        for (int i = 0; i < 8; ++i) {
            const int r = r0 + i;
            u32x4 a = {0, 0, 0, 0}, b = {0, 0, 0, 0};
            if (r < 255) { a = *(const LAS u32x4*)(lds + (r + 1) * TS + c8 * 2); b = *(const LAS u32x4*)(lds + (r + 1) * TS + (128 + c8) * 2); }
            unpack8(a, ng); unpack8(b, nu);
            if (r >= jlo && r <= jhi) {
                float o[8];
#pragma unroll
                for (int j = 0; j < 8; ++j) {
                    const float g = pg[j] * wg[0][j] + cg_[j] * wg[1][j] + ng[j] * wg[2][j] + bg[j];
                    const float up = pu[j] * wu[0][j] + cu[j] * wu[1][j] + nu[j] * wu[2][j] + bu[j];
                    o[j] = gelu_f(g) * up;
                }
                *(u32x4*)(act + (size_t)(tok0 + r) * DFF + gcol) = pack8(o);
            }
#pragma unroll
            for (int j = 0; j < 8; ++j) { pg[j] = cg_[j]; pu[j] = cu[j]; cg_[j] = ng[j]; cu[j] = nu[j]; }
        }
        __syncthreads();
    }
};

constexpr int FFN_MT = 136 + 67, FFN_UNITS = FFN_MT * 22;
DI void ffn_decode(int mt, int& s0, int& L, int& ti) { if (mt < 136) { s0 = (mt / 17) * 4096; ti = mt % 17; L = 4096; } else { s0 = NTP; ti = mt - 136; L = 16384; } }
struct FfnOrder {
    int G, vb;
    DI bool next(int i, Unit& u) const {
        const int t = i * G + vb; if (t >= FFN_UNITS) return false;
        int mt, pn;
        constexpr int BS = 6, NFULL = 22 / BS, REM = 22 - NFULL * BS;
        if (t < NFULL * BS * FFN_MT) { const int blk = t / (BS * FFN_MT), r = t % (BS * FFN_MT); mt = r / BS; pn = blk * BS + r % BS; }
        else { const int r = t - NFULL * BS * FFN_MT; mt = r / REM; pn = NFULL * BS + r % REM; }
        int s0, L, ti; ffn_decode(mt, s0, L, ti);
        u.pm = mt; u.pn = pn; u.arow = s0 + 248 * ti - 1; return true;
    }
};
DI f32x4 dpp_rot(const f32x4& v, bool one) {
    f32x4 r;
#pragma unroll
    for (int j = 0; j < 4; ++j) {
        const int x = __float_as_int(v[j]);
        r[j] = __int_as_float(one ? __builtin_amdgcn_update_dpp(0, x, 0x121, 0xf, 0xf, true) : __builtin_amdgcn_update_dpp(0, x, 0x12F, 0xf, 0xf, true));
    }
    return r;
}
DI f32x4 sel4(bool c, const f32x4& a, const f32x4& b) { f32x4 r; r[0] = c ? a[0] : b[0]; r[1] = c ? a[1] : b[1]; r[2] = c ? a[2] : b[2]; r[3] = c ? a[3] : b[3]; return r; }
struct EpiFfnReg {
    static constexpr bool AFTER_DRAIN = false, PREFETCH = true;
    static constexpr int XOFF = 131072;
    bf16_t* act; const float* cw; const float* cb; const float* ss;
    DI void prefetch(const Unit& u, LAS unsigned char* lds, int wid, int lane, int buf) const {
        if (wid < 4) {
            const int a = 2 * wid + (lane >> 5), k = a & 3;
            const float* src = (k < 3 ? cw + (size_t)k * NFF2 : cb) + (a >= 4 ? DFF : 0) + u.pn * 128 + (lane & 31) * 4;
            __builtin_amdgcn_global_load_lds((const unsigned*)src, (LAS unsigned*)(lds + XOFF + buf * 4096 + wid * 1024), 16, 0, 0);
        } else if (wid == 4) {
            int s0, L, ti; ffn_decode(u.pm, s0, L, ti);
            const int start = (s0 + 248 * ti - 1) & ~3;
            __builtin_amdgcn_global_load_lds((const unsigned*)(ss + start + lane * 4), (LAS unsigned*)(lds + XOFF + 8192 + buf * 1024), 16, 0, 0);
        }
    }
    DI void operator()(const f32x4 (&)[2][2][4][2], const Unit&, int, int, int, int) const {}
    DI void run(const f32x4 (&acc)[2][2][4][2], const Unit& u, int wr, int wc, int fr, int fq, LAS unsigned char* lds, int buf) const {
        int s0, L, ti; ffn_decode(u.pm, s0, L, ti);
        const LAS float* wl = (const LAS float*)(lds + XOFF + buf * 4096);
        const LAS float* sl = (const LAS float*)(lds + XOFF + 8192 + buf * 1024) - ((s0 + 248 * ti - 1) & ~3);
        float rsv[2][4];
#pragma unroll
        for (int ai = 0; ai < 2; ++ai)
#pragma unroll
            for (int m = 0; m < 4; ++m) { int p_ = 248 * ti + 62 * (2 * ai + wr) - 1 + 16 * m + fr; p_ = p_ < 0 ? 0 : (p_ > L - 1 ? L - 1 : p_); rsv[ai][m] = __builtin_amdgcn_rsqf(sl[s0 + p_] * (1.0f / 1024.0f) + EPSV); }
        const int gcol = u.pn * 128 + wc * 32 + 8 * fq;
        const bool is15 = (fr == 15), is0 = (fr == 0);
#pragma unroll
        for (int n = 0; n < 2; ++n) {
            const int gc = gcol + 4 * n, lc = wc * 32 + 8 * fq + 4 * n;
            const f32x4 wg0 = *(const LAS f32x4*)(wl + lc), wg1 = *(const LAS f32x4*)(wl + 128 + lc), wg2 = *(const LAS f32x4*)(wl + 256 + lc), bgv = *(const LAS f32x4*)(wl + 384 + lc);
            const f32x4 wu0 = *(const LAS f32x4*)(wl + 512 + lc), wu1 = *(const LAS f32x4*)(wl + 640 + lc), wu2 = *(const LAS f32x4*)(wl + 768 + lc), buv = *(const LAS f32x4*)(wl + 896 + lc);
#pragma unroll
            for (int ai = 0; ai < 2; ++ai) {
                const int posb = 248 * ti + 62 * (2 * ai + wr) - 1;
                f32x4 sg[4], su[4];
#pragma unroll
                for (int m = 0; m < 4; ++m) { sg[m] = acc[ai][0][m][n] * rsv[ai][m]; su[m] = acc[ai][1][m][n] * rsv[ai][m]; }
#pragma unroll
                for (int m = 0; m < 4; ++m) {
                    const int rho = 16 * m + fr, pos = posb + rho;
                    const f32x4 xg = sg[m], xu = su[m];
                    const f32x4 zpg = (m > 0) ? sel4(is15, sg[m > 0 ? m - 1 : 0], xg) : xg;
                    const f32x4 zpu = (m > 0) ? sel4(is15, su[m > 0 ? m - 1 : 0], xu) : xu;
                    const f32x4 zng = (m < 3) ? sel4(is0, sg[m < 3 ? m + 1 : 3], xg) : xg;
                    const f32x4 znu = (m < 3) ? sel4(is0, su[m < 3 ? m + 1 : 3], xu) : xu;
                    const f32x4 pg = dpp_rot(zpg, true), pu = dpp_rot(zpu, true), ng = dpp_rot(zng, false), nu = dpp_rot(znu, false);
                    f32x4 g = pg * wg0 + xg * wg1 + ng * wg2 + bgv;
                    f32x4 up = pu * wu0 + xu * wu1 + nu * wu2 + buv;
                    if (posb + 16 * m <= 0 && posb + 16 * m + 15 >= 0) { if (pos == 0) { g = xg * wg1 + ng * wg2 + bgv; up = xu * wu1 + nu * wu2 + buv; } }
                    if (posb + 16 * m <= L - 1 && posb + 16 * m + 15 >= L - 1) { if (pos == L - 1) { g = g - ng * wg2; up = up - nu * wu2; } }
                    if (rho >= 1 && rho <= 62 && pos < L) {
                        u32x2 ov; ov.x = pk2(gelu_f(g[0]) * up[0], gelu_f(g[1]) * up[1]); ov.y = pk2(gelu_f(g[2]) * up[2], gelu_f(g[3]) * up[3]);
                        *(u32x2*)(act + (size_t)(s0 + pos) * DFF + gc) = ov;
                    }
                }
            }
        }
    }
    DI void fused(const f32x4 (&)[2][2][4][2], const Unit&, int, int, int, int, LAS unsigned char*, int) const {}
};

template <class Epi, class Sched, bool ALIGN_EPI, int KDIM, int SEG = 64>
DI void gemm_phase(LAS unsigned char* lds, const Gemm g, const Sched& S, const Epi& E) {
    const int tid = opaque_v(threadIdx.x), wid = __builtin_amdgcn_readfirstlane(tid >> 6), lane = tid & 63, wr = wid >> 2, wc = wid & 3, fr = lane & 15, fq = lane >> 4;
    constexpr int K = KDIM, nt = K / BK;
    unsigned voffA[2], voffB[2];
#pragma unroll
    for (int i = 0; i < 2; ++i) { int R, C; stage_rc(tid * 16 + i * 8192, R, C); const int Rb = (R & ~31) + perm32(R & 31);
        voffA[i] = (unsigned)((SEG * (R >> 6) + (R & 63)) * K + C) * 2u; voffB[i] = (unsigned)(Rb * K + C) * 2u; }
    constexpr size_t kstep = (size_t)(BK * 2);
    constexpr size_t hstep = (size_t)HALF * K * 2;
    constexpr size_t hstepA = (size_t)(2 * SEG) * K * 2;
    constexpr size_t tstep = 2 * hstep;
    constexpr size_t rstep = (size_t)K * 2;
    const unsigned ldsw = (unsigned)wid * 1024u;
    const int aoff = lds_byte(wr * 64 + fr, fq * 8), boff = lds_byte(wc * 32 + fr, fq * 8);
#define G_SA(b, h) (((b) * 2 + (h)) * HTB)
#define G_SB(b, h) ((4 + (b) * 2 + (h)) * HTB)
#define G_STAGE(bufoff, gbase, voff) do { _Pragma("unroll") for (int _i = 0; _i < 2; ++_i) \
        __builtin_amdgcn_global_load_lds((const unsigned*)((const char*)(gbase) + (voff)[_i]), (LAS unsigned*)(lds + (bufoff) + ldsw + _i * 8192), 16, 0, 0); } while (0)
#define G_LDA(dst, b, h) do { _Pragma("unroll") for (int m = 0; m < 4; ++m) _Pragma("unroll") for (int k = 0; k < 2; ++k) dst[m][k] = *(const LAS bf16x8*)(lds + G_SA(b, h) + aoff + m * 2048 + k * 1024); } while (0)
#define G_LDB(dst, b, h) do { _Pragma("unroll") for (int n = 0; n < 2; ++n) _Pragma("unroll") for (int k = 0; k < 2; ++k) dst[n][k] = *(const LAS bf16x8*)(lds + G_SB(b, h) + boff + n * 2048 + k * 1024); } while (0)
#define G_MMA(ai, bj, At, Bt) do { __builtin_amdgcn_s_setprio(1); _Pragma("unroll") for (int m = 0; m < 4; ++m) _Pragma("unroll") for (int n = 0; n < 2; ++n) _Pragma("unroll") for (int k = 0; k < 2; ++k) \
        acc[ai][bj][m][n] = __builtin_amdgcn_mfma_f32_16x16x32_bf16(Bt[n][k], At[m][k], acc[ai][bj][m][n], 0, 0, 0); __builtin_amdgcn_s_setprio(0); } while (0)
#define G_WAIT_V(n) asm volatile("s_waitcnt vmcnt(" #n ")" ::: "memory")
#define G_WAIT_L(n) asm volatile("s_waitcnt lgkmcnt(" #n ")" ::: "memory")
#define G_BAR __builtin_amdgcn_s_barrier()
#define G_SCHED __builtin_amdgcn_sched_barrier(0)
    Unit cur, nxt; int ui = 0;
    if (!S.next(0, cur)) return;
    f32x4 acc[2][2][4][2];
#pragma unroll
    for (int a = 0; a < 2; ++a)
#pragma unroll
        for (int b = 0; b < 2; ++b)
#pragma unroll
            for (int m = 0; m < 4; ++m)
#pragma unroll
                for (int n = 0; n < 2; ++n) acc[a][b][m][n] = (f32x4){0.f, 0.f, 0.f, 0.f};
    bf16x8 At[4][2], B0[2][2], B1[2][2];
    const char* cA = (const char*)g.A + (size_t)cur.arow * rstep; const char* cB = (const char*)g.Bt + (size_t)cur.pn * tstep;
    if constexpr (Epi::PREFETCH) E.prefetch(cur, lds, wid, lane, 0);
    G_STAGE(G_SB(0, 0), cB, voffB); G_STAGE(G_SB(0, 1), cB + hstep, voffB); G_STAGE(G_SA(0, 0), cA, voffA); G_STAGE(G_SA(0, 1), cA + hstepA, voffA);
    if (wr == 1) G_BAR;
    G_WAIT_V(2); G_BAR;
    G_STAGE(G_SB(1, 0), cB + kstep, voffB); G_STAGE(G_SA(1, 0), cA + kstep, voffA); G_STAGE(G_SB(1, 1), cB + hstep + kstep, voffB);
    G_WAIT_V(6); G_BAR;
    for (;;) {
        const bool has_next = S.next(ui + 1, nxt);
        const char* nA = has_next ? (const char*)g.A + (size_t)nxt.arow * rstep : cA; const char* nB = has_next ? (const char*)g.Bt + (size_t)nxt.pn * tstep : cB;
        for (int t = 0; t < nt; t += 2) {
            const bool last = (t == nt - 2);
            const char* a1 = cA + (size_t)(t + 1) * kstep;
            const char* a2 = last ? nA : cA + (size_t)(t + 2) * kstep; const char* b2 = last ? nB : cB + (size_t)(t + 2) * kstep;
            const char* a3 = a2 + kstep; const char* b3 = b2 + kstep;
            G_LDB(B0, 0, 0); G_LDB(B1, 0, 1); G_SCHED; G_LDA(At, 0, 0); G_STAGE(G_SA(1, 1), a1 + hstepA, voffA);
            G_WAIT_V(8); G_WAIT_L(0); G_BAR; G_MMA(0, 0, At, B0); G_MMA(0, 1, At, B1); G_BAR; G_SCHED;
            G_LDA(At, 0, 1); G_STAGE(G_SB(0, 0), b2, voffB); G_STAGE(G_SB(0, 1), b2 + hstep, voffB); G_STAGE(G_SA(0, 0), a2, voffA);
            G_WAIT_V(8); G_WAIT_L(0); G_BAR; G_MMA(1, 0, At, B0); G_MMA(1, 1, At, B1); G_BAR; G_SCHED;
            G_LDB(B0, 1, 0); G_LDB(B1, 1, 1); G_SCHED; G_LDA(At, 1, 0); G_STAGE(G_SA(0, 1), a2 + hstepA, voffA);
            G_WAIT_V(8); G_WAIT_L(0); G_BAR; G_MMA(0, 0, At, B0); G_MMA(0, 1, At, B1); G_BAR; G_SCHED;
            G_LDA(At, 1, 1); G_STAGE(G_SB(1, 0), b3, voffB); G_STAGE(G_SB(1, 1), b3 + hstep, voffB); G_STAGE(G_SA(1, 0), a3, voffA);
            G_WAIT_V(8); G_WAIT_L(0); G_BAR; G_MMA(1, 0, At, B0); G_MMA(1, 1, At, B1); G_BAR; G_SCHED;
        }
        if constexpr (ALIGN_EPI) { if (wr == 0) G_BAR; }
        if constexpr (!Epi::AFTER_DRAIN) { if constexpr (Epi::PREFETCH) { E.run(acc, cur, wr, wc, fr, fq, lds, ui & 1); if (has_next) E.prefetch(nxt, lds, wid, lane, (ui + 1) & 1); } else E(acc, cur, wr, wc, fr, fq); }
        if (!has_next) break;
#pragma unroll
        for (int a = 0; a < 2; ++a)
#pragma unroll
            for (int b = 0; b < 2; ++b)
#pragma unroll
                for (int m = 0; m < 4; ++m)
#pragma unroll
                    for (int n = 0; n < 2; ++n) acc[a][b][m][n] = (f32x4){0.f, 0.f, 0.f, 0.f};
        cur = nxt; cA = nA; cB = nB; ++ui;
        if constexpr (ALIGN_EPI) { if (wr == 1) G_BAR; }
    }
    G_WAIT_V(0);
    if constexpr (!ALIGN_EPI) { if (wr == 0) G_BAR; }
    G_BAR;
    if constexpr (Epi::AFTER_DRAIN) { E.fused(acc, cur, wr, wc, fr, fq, lds, tid); }
#undef G_SA
#undef G_SB
#undef G_STAGE
#undef G_LDA
#undef G_LDB
#undef G_MMA
#undef G_WAIT_V
#undef G_WAIT_L
#undef G_BAR
#undef G_SCHED
}
}


#define XB_TMO      128
#define XB_XCNT(j)  (256  + 64 * (j))
#define XB_XSUB(j)  (1280 + 64 * (j))
#define XB_XGEN(j)  (2304 + 64 * (j))
#define XB_TOP      3328
#define XB_TOPGEN   3392
#define XCD_BAR_WORDS 3456
#define XB_SPIN_CAP (1u << 18)
DI unsigned xb_ld(unsigned* p)              { return __hip_atomic_load(p, __ATOMIC_RELAXED, __HIP_MEMORY_SCOPE_AGENT); }
DI unsigned xb_add(unsigned* p, unsigned v) { return __hip_atomic_fetch_add(p, v, __ATOMIC_RELAXED, __HIP_MEMORY_SCOPE_AGENT); }
DI unsigned xb_xcc_id() { return (unsigned)__builtin_amdgcn_s_getreg((3 << 11) | 20) & 0xFu; }
#define XB_SPIN(cond, bar) do { unsigned _sp = 0; while (cond) { __builtin_amdgcn_s_sleep(1); \
    if ((++_sp & 255u) == 0u) { if (xb_ld(&(bar)[XB_TMO])) break; if (_sp > XB_SPIN_CAP) { atomicAdd(&(bar)[XB_TMO], 1u); break; } } } } while (0)
struct XcdBarrier { unsigned* bar; unsigned x; volatile LAS unsigned* st; };
DI XcdBarrier xcd_barrier_post(unsigned* bar, volatile LAS unsigned* st) {
    XcdBarrier b; b.bar = bar; b.x = xb_xcc_id(); b.st = st;
    if (threadIdx.x == 0) (void)xb_add(&bar[XB_XCNT(b.x)], 1u);
    return b;
}
DI void xcd_barrier_complete(unsigned* bar, unsigned x, unsigned& nloc, unsigned& nx) {
    const unsigned G = gridDim.x * gridDim.y * gridDim.z;
    unsigned sum, cnt, mine, sp = 0u;
    for (;;) {
        sum = 0u; cnt = 0u; mine = 0u;
#pragma unroll
        for (unsigned j = 0; j < 16; ++j) { const unsigned c = xb_ld(&bar[XB_XCNT(j)]); sum += c; cnt += (c > 0u) ? 1u : 0u; mine = (j == x) ? c : mine; }
        if (sum == G) break;
        __builtin_amdgcn_s_sleep(1);
        if ((++sp & 255u) == 0u) { if (xb_ld(&bar[XB_TMO])) break; if (sp > XB_SPIN_CAP) { atomicAdd(&bar[XB_TMO], 1u); break; } }
    }
    nloc = mine > 0u ? mine : 1u; nx = cnt > 0u ? cnt : 1u;
}
DI void xcd_barrier(const XcdBarrier& b) {
    asm volatile("s_waitcnt vmcnt(0)" ::: "memory");
    __syncthreads();
    if (threadIdx.x == 0) {
        unsigned* bar = b.bar;
        asm volatile("" : "+s"(bar));
        unsigned bx = b.x; asm volatile("" : "+s"(bx));
        __builtin_amdgcn_s_waitcnt(0);
        unsigned nloc = b.st[0], nx = b.st[1];
        if (nloc == 0u) { xcd_barrier_complete(bar, bx, nloc, nx); b.st[0] = nloc; b.st[1] = nx; }
        const unsigned old = xb_add(&bar[XB_XSUB(bx)], 1u);
        const unsigned gen = old / nloc;
        if (old + 1u == (gen + 1u) * nloc) {
            __builtin_amdgcn_fence(__ATOMIC_RELEASE, "agent");
            asm volatile("s_waitcnt vmcnt(0)" ::: "memory");
            const unsigned og = xb_add(&bar[XB_TOP], 1u);
            const unsigned tg = og / nx;
            if (og + 1u == (tg + 1u) * nx) xb_add(&bar[XB_TOPGEN], 1u);
            else XB_SPIN(xb_ld(&bar[XB_TOPGEN]) == tg, bar);
            __builtin_amdgcn_fence(__ATOMIC_ACQUIRE, "agent");
            xb_add(&bar[XB_XGEN(bx)], 1u);
            asm volatile("s_waitcnt vmcnt(0)" ::: "memory");
        } else {
            XB_SPIN(xb_ld(&bar[XB_XGEN(bx)]) == gen, bar);
            __builtin_amdgcn_fence(__ATOMIC_ACQUIRE, "agent");
            asm volatile("s_waitcnt vmcnt(0)" ::: "memory");
        }
    }
    __syncthreads();
}

struct TrTile { const float* src; bf16_t* dst; const float* gk; int N, K; };
DI TrTile tr_decode(KP P, unsigned char* ws, int u) {
    const int l = u / 2816, t = u % 2816;
    const float* W; bf16_t* Wt; const float* gv = nullptr; int K, N, tile; bool perm = false;
    if (t < 448) { W = P->in[3] + (size_t)l * 1024 * 1792; K = 1024; N = 1792; Wt = (bf16_t*)(ws + WS_WIN) + (size_t)l * 1792 * 1024; tile = t; gv = P->in[2] + l * 1024; }
    else if (t < 704) { W = P->in[20] + (size_t)l * 1024 * 1024; K = 1024; N = 1024; Wt = (bf16_t*)(ws + WS_WOUT) + (size_t)l * 1024 * 1024; tile = t - 448; }
    else if (t < 2112) { W = P->in[22] + (size_t)l * 1024 * 5632; K = 1024; N = 5632; Wt = (bf16_t*)(ws + WS_WF1) + (size_t)l * 5632 * 1024; tile = t - 704; perm = true; gv = P->in[21] + l * 1024; }
    else { W = P->in[25] + (size_t)l * 2816 * 1024; K = 2816; N = 1024; Wt = (bf16_t*)(ws + WS_WF2) + (size_t)l * 1024 * 2816; tile = t - 2112; }
    const int nk = K / 64, ntile = tile / nk, kt = tile % nk, n0 = ntile * 64, k0 = kt * 64;
    int sn0 = n0;
    if (perm) { const int pn = n0 >> 8, j = n0 & 255; sn0 = (j < 128) ? pn * 128 + j : DFF + pn * 128 + (j - 128); }
    TrTile r; r.src = W + (size_t)k0 * N + sn0; r.dst = Wt + (size_t)n0 * K + k0; r.gk = gv ? gv + k0 : nullptr; r.N = N; r.K = K; return r;
}
DI void transpose_group(KP P, unsigned char* ws, int grp, unsigned char* lds, int tid_) {
    const int tid = opaque_v(tid_);
    float* T = (float*)lds;
    f32x4 v[4][2];
#pragma unroll
    for (int j = 0; j < 4; ++j) {
        const TrTile t = tr_decode(P, ws, grp * 4 + j);
#pragma unroll
        for (int ps = 0; ps < 2; ++ps) { const int r = (tid >> 4) + 32 * ps, c4 = (tid & 15) * 4; v[j][ps] = *(const f32x4*)(t.src + (size_t)r * t.N + c4); if (t.gk) v[j][ps] = v[j][ps] * t.gk[r]; }
    }
#pragma unroll
    for (int j = 0; j < 4; ++j)
#pragma unroll
        for (int ps = 0; ps < 2; ++ps) { const int r = (tid >> 4) + 32 * ps, c4 = (tid & 15) * 4; float* Tj = T + j * 4160;
            Tj[(c4 + 0) * 65 + r] = v[j][ps][0]; Tj[(c4 + 1) * 65 + r] = v[j][ps][1]; Tj[(c4 + 2) * 65 + r] = v[j][ps][2]; Tj[(c4 + 3) * 65 + r] = v[j][ps][3]; }
    __syncthreads();
#pragma unroll
    for (int j = 0; j < 4; ++j) {
        const TrTile t = tr_decode(P, ws, grp * 4 + j);
        const int n = tid >> 3, kc = (tid & 7) * 8; const float* Tj = T + j * 4160;
        float f[8];
#pragma unroll
        for (int q = 0; q < 8; ++q) f[q] = Tj[n * 65 + kc + q];
        *(u32x4*)(t.dst + (size_t)n * t.K + kc) = pack8(f);
    }
    __syncthreads();
}

DI void xb_rows(const float* src0, const float* src1, bf16_t* XB, float* SS, int tid_, int bid, int G) {
    const int tid = opaque_v(tid_);
    const int w = tid >> 6, lane = tid & 63;
    for (int i = bid * 512 + tid; i < 3 * NT; i += G * 512) SS[NT + i] = 0.f;
    const int stride = G * 8;
    for (int row = bid * 8 + w; row < NT; row += 2 * stride) {
        const int row2 = row + stride; const bool has2 = row2 < NT;
        const float* sp = (row < NTP) ? src0 + (size_t)row * DM : src1 + (size_t)(row - NTP) * DM;
        const int r2 = has2 ? row2 : row;
        const float* sp2 = (r2 < NTP) ? src0 + (size_t)r2 * DM : src1 + (size_t)(r2 - NTP) * DM;
        f32x4 v[4], v2[4]; float ss = 0.f, ss2 = 0.f;
#pragma unroll
        for (int j = 0; j < 4; ++j) { v[j] = *(const f32x4*)(sp + j * 256 + lane * 4); v2[j] = *(const f32x4*)(sp2 + j * 256 + lane * 4); }
#pragma unroll
        for (int j = 0; j < 4; ++j) { ss += v[j][0] * v[j][0] + v[j][1] * v[j][1] + v[j][2] * v[j][2] + v[j][3] * v[j][3];
            ss2 += v2[j][0] * v2[j][0] + v2[j][1] * v2[j][1] + v2[j][2] * v2[j][2] + v2[j][3] * v2[j][3]; }
        ss = wave_sum(ss); ss2 = wave_sum(ss2);
#pragma unroll
        for (int j = 0; j < 4; ++j) {
            u32x2 o; o.x = pk2(v[j][0], v[j][1]); o.y = pk2(v[j][2], v[j][3]);
            *(u32x2*)(XB + (size_t)row * DM + j * 256 + lane * 4) = o;
        }
        if (lane == 0) SS[row] = ss;
        if (has2) {
#pragma unroll
            for (int j = 0; j < 4; ++j) {
                u32x2 o; o.x = pk2(v2[j][0], v2[j][1]); o.y = pk2(v2[j][2], v2[j][3]);
                *(u32x2*)(XB + (size_t)row2 * DM + j * 256 + lane * 4) = o;
            }
            if (lane == 0) SS[row2] = ss2;
        }
    }
}

DI void filter_tile(KP P, int l, int kind, int tile, unsigned char* lds, int tid_) {
    const int tid = opaque_v(tid_);
    const int L = kind ? 4096 : 16384, KRL = kind ? KRP_LEN : KRS_LEN;
    bf16_t* KR = (bf16_t*)(P->ws + (kind ? WS_KRP : WS_KRS)) + (size_t)l * 2 * 256 * KRL;
    const float* w1 = P->in[11] + l * 33 * 64; const float* b1 = P->in[12] + l * 64; const float* f1 = P->in[13] + l * 64;
    const float* w2 = P->in[14] + l * 64 * 64; const float* b2 = P->in[15] + l * 64; const float* f2 = P->in[16] + l * 64;
    const float* w3 = P->in[17] + (size_t)l * 64 * 1024; const float* hb = P->in[18] + l * 2 * 256;
    float* Z = (float*)lds;
    float* H1 = Z + 64 * 33;
    float* H2 = H1 + 64 * 64;
    bf16_t* OUT = (bf16_t*)(H2 + 64 * 64);
    const int t0 = tile * 64;
    for (int idx = tid; idx < 64 * 33; idx += 512) {
        const int t = idx / 33, e = idx % 33, n = t0 + t;
        float v;
        if (e == 0) v = (float)n / (float)(L - 1);
        else {
            const int bi = (e - 1) & 15;
            const float band = 1e-4f + (float)bi * ((15.0f - 1e-4f) / 15.0f);
            const float rev = (float)n * band / (float)L;
            v = (e <= 16) ? cos_rev(rev) : -sin_rev(rev);
        }
        Z[idx] = v;
    }
    __syncthreads();
    {
        const int j = tid & 63, tg = tid >> 6;
        float a[8];
#pragma unroll
        for (int i = 0; i < 8; ++i) a[i] = b1[j];
        for (int e = 0; e < 33; ++e) { const float w = w1[e * 64 + j];
#pragma unroll
            for (int i = 0; i < 8; ++i) a[i] += Z[(tg * 8 + i) * 33 + e] * w; }
        const float fr = f1[j];
#pragma unroll
        for (int i = 0; i < 8; ++i) H1[(tg * 8 + i) * 64 + j] = sin_rad(fr * a[i]);
    }
    __syncthreads();
    {
        const int j = tid & 63, tg = tid >> 6;
        float a[8];
#pragma unroll
        for (int i = 0; i < 8; ++i) a[i] = b2[j];
        for (int e = 0; e < 64; ++e) { const float w = w2[e * 64 + j];
#pragma unroll
            for (int i = 0; i < 8; ++i) a[i] += H1[(tg * 8 + i) * 64 + e] * w; }
        const float fr = f2[j];
#pragma unroll
        for (int i = 0; i < 8; ++i) H2[(tg * 8 + i) * 64 + j] = sin_rad(fr * a[i]);
    }
    __syncthreads();
    const int w = tid >> 6, lane = tid & 63, n = lane & 31, h = lane >> 5;
    bf16x8 afrag[2][4];
#pragma unroll
    for (int mb = 0; mb < 2; ++mb)
#pragma unroll
        for (int ks = 0; ks < 4; ++ks) {
            const float* hp = H2 + (mb * 32 + n) * 64 + ks * 16 + 8 * h;
            const f32x4 x0 = *(const f32x4*)hp, x1 = *(const f32x4*)(hp + 4);
            u32x4 pw; pw.x = pk2(x0[0], x0[1]); pw.y = pk2(x0[2], x0[3]); pw.z = pk2(x1[0], x1[1]); pw.w = pk2(x1[2], x1[3]);
            afrag[mb][ks] = __builtin_bit_cast(bf16x8, pw);
        }
    const int c = w * 32 + n;
    const float min_decay = -4.605170185988091f / 1.5f, max_decay = -4.605170185988091f / 0.3f;
    const float delta = fabsf(min_decay + (float)c * ((max_decay - min_decay) / 255.0f));
    for (int f = 0; f < 4; ++f) {
        f32x16 acc[2];
#pragma unroll
        for (int mb = 0; mb < 2; ++mb)
#pragma unroll
            for (int i = 0; i < 16; ++i) acc[mb][i] = 0.f;
#pragma unroll
        for (int ks = 0; ks < 4; ++ks) {
            const float* wp = w3 + (size_t)(ks * 16 + 8 * h) * 1024 + f * 256 + c;
            float wv[8];
#pragma unroll
            for (int j = 0; j < 8; ++j) wv[j] = wp[j * 1024];
            const bf16x8 bfrag = __builtin_bit_cast(bf16x8, pack8(wv));
#pragma unroll
            for (int mb = 0; mb < 2; ++mb) acc[mb] = __builtin_amdgcn_mfma_f32_32x32x16_bf16(afrag[mb][ks], bfrag, acc[mb], 0, 0, 0);
        }
#pragma unroll
        for (int mb = 0; mb < 2; ++mb)
#pragma unroll
            for (int i = 0; i < 16; ++i) {
                const int t = mb * 32 + crow(i, h);
                const float tn = (float)(t0 + t) / (float)(L - 1);
                float v = acc[mb][i] * __expf(-tn * delta);
                if ((f & 1) == 0 && (t0 + t) == 0) v += hb[(f >> 1) * 256 + c];
                OUT[c * 72 + t] = f2bf(v);
            }
        __syncthreads();
        const int o = f >> 1;
        for (int item = tid; item < 256 * 64; item += 512) {
            const int cc = item >> 6, t = item & 63, nn = t0 + t;
            bf16_t* arr = KR + (size_t)(o * 256 + cc) * KRL;
            const bf16_t v = OUT[cc * 72 + t];
            if ((f & 1) == 0) arr[KR_PAD + L - nn] = v;
            else if (nn > 0) arr[KR_PAD + L + nn] = v;
        }
        __syncthreads();
    }
}

DI void attn_unit(KP P, int l, int unit, unsigned char* lds, int tid_) {
    const int tid = opaque_v(tid_);
    const unsigned z0_ = (unsigned)opaque_v(0); const u32x4 zero4 = {z0_, z0_, z0_, z0_};
    const bf16_t* Pm = (const bf16_t*)(P->ws + WS_P);
    bf16_t* HB = (bf16_t*)(P->out);
    const int qb = unit >> 1, g = unit & 1;
    const int tokq0 = qb * 128; int s0, L; seq_info(tokq0, s0, L);
    const int pos0 = tokq0 - s0;
    bf16_t* Kl = (bf16_t*)lds;
    bf16_t* Vt = (bf16_t*)(lds + 55296);
    const float* kng = P->in[5] + l * 64; const float* qng = P->in[4] + l * 64;
#pragma unroll
    for (int j_ = 0; j_ < 6; ++j_) {
        const int item = tid + 512 * j_;
        const int i = item >> 3, ch = item & 7, kpos = pos0 - 128 + i;
        u32x4 raw = zero4;
        if (kpos >= 0 && kpos < L) raw = *(const u32x4*)(Pm + (size_t)(s0 + kpos) * NIN + 512 + g * 64 + ch * 8);
        float f[8]; unpack8(raw, f);
        float ss = 0.f;
#pragma unroll
        for (int j = 0; j < 8; ++j) ss += f[j] * f[j];
        ss += __shfl_xor(ss, 1); ss += __shfl_xor(ss, 2); ss += __shfl_xor(ss, 4);
        const float rs = rsqrtf(ss * (1.0f / 64.0f) + EPSV);
#pragma unroll
        for (int j = 0; j < 8; ++j) f[j] *= rs * kng[ch * 8 + j];
        *(u32x4*)(Kl + i * 72 + ch * 8) = pack8(f);
    }
#pragma unroll
    for (int j_ = 0; j_ < 6; ++j_) {
        const int item = tid + 512 * j_;
        const int ch = item / 384, i = item % 384, kpos = pos0 - 128 + i;
        u32x4 raw = zero4;
        if (kpos >= 0 && kpos < L) raw = *(const u32x4*)(Pm + (size_t)(s0 + kpos) * NIN + 640 + g * 64 + ch * 8);
        bf16_t* vp = Vt + (ch * 8) * 392 + i;
        vp[0] = (bf16_t)(raw.x & 0xffff); vp[392] = (bf16_t)(raw.x >> 16); vp[2 * 392] = (bf16_t)(raw.y & 0xffff); vp[3 * 392] = (bf16_t)(raw.y >> 16);
        vp[4 * 392] = (bf16_t)(raw.z & 0xffff); vp[5 * 392] = (bf16_t)(raw.z >> 16); vp[6 * 392] = (bf16_t)(raw.w & 0xffff); vp[7 * 392] = (bf16_t)(raw.w >> 16);
    }
    __syncthreads();
    const int w = __builtin_amdgcn_readfirstlane(tid >> 6), lane = tid & 63, r = lane & 31, h = lane >> 5;
    const int hq = g * 4 + (w >> 1), qoff = (w & 1) * 64;
    const float slope2 = exp2f(-(float)(hq + 1)) * LOG2E;
    const float sink2 = P->in[6][l * 8 + hq] * LOG2E;
    const float qscale = 0.125f * LOG2E;
    bf16x8 qf[2][4];
#pragma unroll
    for (int qg = 0; qg < 2; ++qg) {
        const int tok = tokq0 + qoff + qg * 32 + r;
        u32x4 raw[4]; float ss = 0.f;
#pragma unroll
        for (int c = 0; c < 4; ++c) { raw[c] = *(const u32x4*)(Pm + (size_t)tok * NIN + hq * 64 + 16 * c + 8 * h);
            float f[8]; unpack8(raw[c], f);
#pragma unroll
            for (int j = 0; j < 8; ++j) ss += f[j] * f[j]; }
        ss += __shfl_xor(ss, 32);
        const float rs = rsqrtf(ss * (1.0f / 64.0f) + EPSV) * qscale;
#pragma unroll
        for (int c = 0; c < 4; ++c) { float f[8]; unpack8(raw[c], f);
#pragma unroll
            for (int j = 0; j < 8; ++j) f[j] *= rs * qng[16 * c + 8 * h + j];
            qf[qg][c] = __builtin_bit_cast(bf16x8, pack8(f)); }
    }
    f32x16 o[2][2]; float rsum[2] = {0.f, 0.f};
#pragma unroll
    for (int a = 0; a < 2; ++a)
#pragma unroll
        for (int b = 0; b < 2; ++b)
#pragma unroll
            for (int i = 0; i < 16; ++i) o[a][b][i] = 0.f;
    const int kb_lo = qoff >> 5;
    for (int kb = kb_lo; kb < kb_lo + 10; ++kb) {
        const int i0 = kb * 32;
        bf16x8 kf[4];
#pragma unroll
        for (int c = 0; c < 4; ++c) kf[c] = *(const bf16x8*)(Kl + (i0 + r) * 72 + 16 * c + 8 * h);
        bf16x8 pf[2][2];
#pragma unroll
        for (int qg = 0; qg < 2; ++qg) {
            f32x16 s;
#pragma unroll
            for (int i = 0; i < 16; ++i) s[i] = 0.f;
#pragma unroll
            for (int c = 0; c < 4; ++c) s = __builtin_amdgcn_mfma_f32_32x32x16_bf16(kf[c], qf[qg][c], s, 0, 0, 0);
            const int qrel = qoff + qg * 32 + r + 128;
            float pv[16];
            const int rel = i0 - (qoff + qg * 32 + 128);
            const bool inseq = (pos0 - 128 + i0 >= 0) && (pos0 - 128 + i0 + 31 < L);
            if (rel < -128 || rel > 128) {
#pragma unroll
                for (int i = 0; i < 16; ++i) pv[i] = 0.f;
            } else if (inseq && rel != 0 && rel >= -96 && rel <= 96) {
                const float ssl = rel < 0 ? slope2 : -slope2;
                const float base = ssl * (float)(i0 + 4 * h - qrel);
#pragma unroll
                for (int i = 0; i < 16; ++i) {
                    const float e = __builtin_amdgcn_exp2f(s[i] + (base + ssl * (float)crow(i, 0)));
                    pv[i] = e; rsum[qg] += e;
                }
            } else {
#pragma unroll
                for (int i = 0; i < 16; ++i) {
                    const int ki = i0 + crow(i, h);
                    int dist = qrel - ki; dist = dist < 0 ? -dist : dist;
                    const int kpos = pos0 - 128 + ki;
                    const bool valid = (dist <= 128) && (kpos >= 0) && (kpos < L);
                    const float e = __builtin_amdgcn_exp2f(s[i] - slope2 * (float)dist);
                    pv[i] = valid ? e : 0.f;
                    rsum[qg] += pv[i];
                }
            }
#pragma unroll
            for (int sx = 0; sx < 2; ++sx) {
                u32x4 pw; pw.x = pk2(pv[8 * sx], pv[8 * sx + 1]); pw.y = pk2(pv[8 * sx + 2], pv[8 * sx + 3]); pw.z = pk2(pv[8 * sx + 4], pv[8 * sx + 5]); pw.w = pk2(pv[8 * sx + 6], pv[8 * sx + 7]);
                pf[qg][sx] = __builtin_bit_cast(bf16x8, pw);
            }
        }
#pragma unroll
        for (int dt = 0; dt < 2; ++dt)
#pragma unroll
            for (int sx = 0; sx < 2; ++sx) {
                const bf16_t* vb = Vt + (dt * 32 + r) * 392 + i0 + 16 * sx + 4 * h;
                const u32x2 lo = *(const u32x2*)vb, hi = *(const u32x2*)(vb + 8);
                u32x4 vv; vv.x = lo.x; vv.y = lo.y; vv.z = hi.x; vv.w = hi.y;
                const bf16x8 vf = __builtin_bit_cast(bf16x8, vv);
#pragma unroll
                for (int qg = 0; qg < 2; ++qg) o[qg][dt] = __builtin_amdgcn_mfma_f32_32x32x16_bf16(vf, pf[qg][sx], o[qg][dt], 0, 0, 0);
            }
    }
#pragma unroll
    for (int qg = 0; qg < 2; ++qg) {
        float lsum = rsum[qg] + __shfl_xor(rsum[qg], 32) + __builtin_amdgcn_exp2f(sink2);
        const float inv = 1.0f / lsum;
        const int tok = tokq0 + qoff + qg * 32 + r;
#pragma unroll
        for (int dt = 0; dt < 2; ++dt)
#pragma unroll
            for (int gq = 0; gq < 4; ++gq) {
                u32x2 ov; ov.x = pk2(o[qg][dt][4 * gq] * inv, o[qg][dt][4 * gq + 1] * inv); ov.y = pk2(o[qg][dt][4 * gq + 2] * inv, o[qg][dt][4 * gq + 3] * inv);
                *(u32x2*)(HB + (size_t)tok * DM + hq * 64 + dt * 32 + 8 * gq + 4 * h) = ov;
            }
    }
    __syncthreads();
}

DI void pool_unit(KP P, int l, int unit, unsigned char* lds, int tid_) {
    const int tid = opaque_v(tid_);
    const unsigned z0_ = (unsigned)opaque_v(0); const u32x4 zero4 = {z0_, z0_, z0_, z0_};
    const bf16_t* Pm = (const bf16_t*)(P->ws + WS_P);
    bf16_t* HB = (bf16_t*)(P->out);
    const int tok0 = unit * 64; int s0, L; seq_info(tok0, s0, L);
    const int pos0 = tok0 - s0;
    bf16_t* U = (bf16_t*)lds;
    bf16_t* DT = (bf16_t*)(lds + 40960);
#pragma unroll
    for (int j_ = 0; j_ < 5; ++j_) {
        const int item = tid + 512 * j_;
        const int rr = item >> 5, ch = item & 31, pos = pos0 - 8 + rr;
        u32x4 raw = zero4;
        if (pos >= 0 && pos < L) raw = *(const u32x4*)(Pm + (size_t)(s0 + pos) * NIN + 768 + ch * 8);
        *(u32x4*)(U + rr * 256 + ch * 8) = raw;
    }
    __syncthreads();
    const int c = tid & 255, th = tid >> 8, gi = c >> 6, hw = 1 << gi;
    {
        const int tfirst = th * 32;
        float sum = 0.f;
        for (int s = tfirst - hw; s < tfirst + hw; ++s) sum += bf2f(U[(s + 8) * 256 + c]);
        for (int tt = 0; tt < 32; ++tt) {
            const int t = tfirst + tt, pos = pos0 + t;
            const int lo = max(pos - hw, 0), hi = min(pos + hw, L);
            const float d = sum / (float)(hi - lo) - bf2f(U[(t + 8) * 256 + c]);
            DT[t * 264 + c] = f2bf(d);
            sum += bf2f(U[(t + hw + 8) * 256 + c]) - bf2f(U[(t - hw + 8) * 256 + c]);
        }
    }
    __syncthreads();
    {
        const int w = __builtin_amdgcn_readfirstlane(tid >> 6), lane = tid & 63, n = lane & 31, h = lane >> 5;
        const int g = w >> 1, nb = w & 1;
        const float* W = P->in[7] + (size_t)l * 4 * 64 * 64 + g * 4096 + 32 * nb + n;
        bf16x8 bw[4];
#pragma unroll
        for (int ks = 0; ks < 4; ++ks) {
            float wv[8];
#pragma unroll
            for (int j = 0; j < 8; ++j) wv[j] = W[(16 * ks + 8 * h + j) * 64];
            bw[ks] = __builtin_bit_cast(bf16x8, pack8(wv));
        }
        f32x16 acc[2];
#pragma unroll
        for (int mb = 0; mb < 2; ++mb) {
#pragma unroll
            for (int i = 0; i < 16; ++i) acc[mb][i] = 0.f;
#pragma unroll
            for (int ks = 0; ks < 4; ++ks) {
                const bf16x8 af = *(const bf16x8*)(DT + (32 * mb + n) * 264 + g * 64 + 16 * ks + 8 * h);
                acc[mb] = __builtin_amdgcn_mfma_f32_32x32x16_bf16(af, bw[ks], acc[mb], 0, 0, 0);
            }
        }
        const int oc = g * 64 + 32 * nb + n;
        const float sc = P->in[8][l * 256 + oc];
#pragma unroll
        for (int mb = 0; mb < 2; ++mb)
#pragma unroll
            for (int i = 0; i < 16; ++i) HB[(size_t)(tok0 + 32 * mb + crow(i, h)) * DM + 512 + oc] = f2bf(acc[mb][i] * sc);
    }
    __syncthreads();
}

DI void prep_unit(KP P, int l, int unit, unsigned char* lds, int tid_) {
    const int tid = opaque_v(tid_);
    const unsigned z0_ = (unsigned)opaque_v(0); const u32x4 zero4 = {z0_, z0_, z0_, z0_};
    const bf16_t* Pm = (const bf16_t*)(P->ws + WS_P);
    bf16_t* HY = (bf16_t*)(P->ws + WS_HY);
    const int tok0 = unit * 64; int s0, L; seq_info(tok0, s0, L);
    const int pos0 = tok0 - s0;
    unsigned* Tw = (unsigned*)lds;
    const float* cw = P->in[9] + (size_t)l * 3 * 768; const float* cb = P->in[10] + l * 768;
    if (tid < 480) {
        const int ch = tid % 96, tg = tid / 96, col = ch * 8, tfirst = 13 * tg;
        const f32x4 w0a = *(const f32x4*)(cw + col), w0b = *(const f32x4*)(cw + col + 4), w1a = *(const f32x4*)(cw + 768 + col), w1b = *(const f32x4*)(cw + 768 + col + 4);
        const f32x4 w2a = *(const f32x4*)(cw + 1536 + col), w2b = *(const f32x4*)(cw + 1536 + col + 4), bba = *(const f32x4*)(cb + col), bbb = *(const f32x4*)(cb + col + 4);
        u32x4 rows[15];
#pragma unroll
        for (int r = 0; r < 15; ++r) {
            const int t = tfirst - 1 + r, pos = pos0 + t;
            rows[r] = zero4;
            if (t <= 64 && pos >= 0 && pos < L) rows[r] = *(const u32x4*)(Pm + (size_t)(s0 + pos) * NIN + 1024 + col);
        }
#pragma unroll
        for (int i = 0; i < 13; ++i) {
            const int t = tfirst + i;
            if (t < 64) {
                float fa[8], fb[8], fd[8]; unpack8(rows[i], fa); unpack8(rows[i + 1], fb); unpack8(rows[i + 2], fd);
                bf16_t* Tb = (bf16_t*)(Tw + (((t >> 1) + ch) & 31)) + (t & 1);
#pragma unroll
                for (int j = 0; j < 8; ++j) {
                    const float w0 = j < 4 ? w0a[j & 3] : w0b[j & 3], w1 = j < 4 ? w1a[j & 3] : w1b[j & 3], w2 = j < 4 ? w2a[j & 3] : w2b[j & 3], bb = j < 4 ? bba[j & 3] : bbb[j & 3];
                    const float v = fa[j] * w0 + fb[j] * w1 + fd[j] * w2 + bb;
                    Tb[(col + j) * 66] = f2bf(v);
                }
            }
        }
    }
    __syncthreads();
#pragma unroll 4
    for (int j_ = 0; j_ < 12; ++j_) {
        const int item = tid + 512 * j_;
        const int cc = item >> 3, q = item & 7, rot = cc >> 3;
        const unsigned* rowp = Tw + cc * 33;
        u32x4 v; v.x = rowp[(4 * q + rot) & 31]; v.y = rowp[(4 * q + 1 + rot) & 31]; v.z = rowp[(4 * q + 2 + rot) & 31]; v.w = rowp[(4 * q + 3 + rot) & 31];
        const int arr = cc >> 8, ch = cc & 255;
        *(u32x4*)(HY + (size_t)arr * HY_ARR + (size_t)ch * NT + tok0 + q * 8) = v;
    }
    __syncthreads();
}

template <bool SAMPLE>
DI void hyena_unit(const bf16_t* Uin, const bf16_t* Gate, bf16_t* Zout, const bf16_t* kr, int c, unsigned char* lds, int tid_) {
    const int tid = opaque_v(tid_);
    constexpr int NB = SAMPLE ? 128 : 32;
    constexpr int L = NB * 128;
    constexpr int KRL = 2 * L + 512;
    constexpr int SEQ_STRIDE = 8768;
    constexpr int ZERO_OFF = SAMPLE ? 128 * 272 : 8 * SEQ_STRIDE;
    constexpr int KR_OFF = SAMPLE ? 35328 : 70656;
    const int w = __builtin_amdgcn_readfirstlane(tid >> 6), lane = tid & 63, n = lane & 31, h = lane >> 5;
    {
        constexpr int NU = SAMPLE ? 4 : 8;
        constexpr int NK = (KRL / 8 + 511) / 512;
        u32x4 uv[NU], kv[NK];
#pragma unroll
        for (int j = 0; j < NU; ++j) uv[j] = *(const u32x4*)(Uin + (size_t)c * NT + (SAMPLE ? NTP : 0) + (tid + 512 * j) * 8);
#pragma unroll
        for (int j = 0; j < NK; ++j) { const int item = tid + 512 * j; kv[j] = *(const u32x4*)(kr + (item < KRL / 8 ? item : 0) * 8); }
#pragma unroll
        for (int j = 0; j < NU; ++j) {
            const int t8 = (tid + 512 * j) * 8;
            if (SAMPLE) { const int a = t8 >> 7, wi = t8 & 127; *(u32x4*)(lds + a * 272 + wi * 2) = uv[j]; }
            else { const int b = t8 >> 12, tt = t8 & 4095, a = tt >> 7, wi = tt & 127; *(u32x4*)(lds + b * SEQ_STRIDE + a * 272 + wi * 2) = uv[j]; }
        }
#pragma unroll
        for (int j = 0; j < NK; ++j) { const int item = tid + 512 * j; if (item < KRL / 8) *(u32x4*)(lds + KR_OFF + item * 16) = kv[j]; }
    }
    if (tid < 17) { const unsigned z0_ = (unsigned)opaque_v(0); *(u32x4*)(lds + ZERO_OFF + tid * 16) = (u32x4){z0_, z0_, z0_, z0_}; }
    __syncthreads();
    if (!SAMPLE) {
        constexpr int NCH = KRL / 8;
        for (int task = tid; task < 3 * NCH; task += 512) {
            const int e = task / NCH + 1, ch = task % NCH;
            const unsigned* src = (const unsigned*)(lds + KR_OFF) + ch * 4;
            const u32x4 d03 = *(const u32x4*)src; const unsigned d4 = src[4], d5 = src[5];
            const bool k1 = (e >> 1) != 0; const unsigned shb = (unsigned)(e & 1) * 16u;
            const unsigned e0 = k1 ? d03.y : d03.x, e1 = k1 ? d03.z : d03.y, e2 = k1 ? d03.w : d03.z, e3 = k1 ? d4 : d03.w, e4 = k1 ? d5 : d4;
            u32x4 o; o.x = __builtin_amdgcn_alignbit(e1, e0, shb); o.y = __builtin_amdgcn_alignbit(e2, e1, shb); o.z = __builtin_amdgcn_alignbit(e3, e2, shb); o.w = __builtin_amdgcn_alignbit(e4, e3, shb);
            *(u32x4*)(lds + KR_OFF + e * (KRL * 2) + ch * 16) = o;
        }
        __syncthreads();
    }
    const int a_n = SAMPLE ? 32 * (w & 3) + n : 4 * w + (n & 3);
    const int b_n = SAMPLE ? 0 : (n >> 2);
    const unsigned char* ubase = lds + b_n * SEQ_STRIDE;
    const int dlo = SAMPLE ? 32 * (w & 3) - 127 : 4 * w - 31;
    const int dhi = SAMPLE ? 32 * (w & 3) + 31 : 4 * w + 3;
    const int idxc = 8 * h - n + L + KR_PAD;
    const int esh = (4 - (n & 3)) & 3;
    const bool ek = (esh >> 1) != 0;
    const unsigned sh = (unsigned)(esh & 1) * 16u;
    const unsigned char* lb = lds + KR_OFF + (SAMPLE ? 0 : esh * (KRL * 2)) + (idxc - esh) * 2 - 6 * 32;
    f32x16 acc[4];
#pragma unroll
    for (int r = 0; r < 4; ++r)
#pragma unroll
        for (int i = 0; i < 16; ++i) acc[r][i] = 0.f;
    const int dfirst = SAMPLE ? ((w >> 2) ? dlo + 80 : dlo) : dlo;
    const int dlast = SAMPLE ? ((w >> 2) ? dhi : dlo + 79) : dhi;
    bf16x8 afr[24];
#define HY_FRAG(dst, ab, d) do { const u32x2* p_ = (const u32x2*)((ab) + (d) * 32); \
        if (SAMPLE) { const u32x2 x0 = p_[0], x1 = p_[1], x2 = p_[2]; \
            const unsigned e0 = ek ? x0.y : x0.x, e1 = ek ? x1.x : x0.y, e2 = ek ? x1.y : x1.x, e3 = ek ? x2.x : x1.y, e4 = ek ? x2.y : x2.x; \
            u32x4 o_; o_.x = __builtin_amdgcn_alignbit(e1, e0, sh); o_.y = __builtin_amdgcn_alignbit(e2, e1, sh); o_.z = __builtin_amdgcn_alignbit(e3, e2, sh); o_.w = __builtin_amdgcn_alignbit(e4, e3, sh); \
            dst = __builtin_bit_cast(bf16x8, o_); } \
        else { const u32x2 x0 = p_[0], x1 = p_[1]; u32x4 o_; o_.x = x0.x; o_.y = x0.y; o_.z = x1.x; o_.w = x1.y; dst = __builtin_bit_cast(bf16x8, o_); } } while (0)
#define HY_MMA(SO) do { const int blk = a_n - delta; const bool valid = (blk >= 0) && (blk < NB); \
        const unsigned char* bp = valid ? ubase + blk * 272 + 16 * h : lds + ZERO_OFF + 16 * h; const int qs = valid ? 32 : 0; \
        bf16x8 bfr[8]; \
        _Pragma("unroll") for (int q = 0; q < 8; ++q) bfr[q] = *(const bf16x8*)(bp + qs * q); \
        __builtin_amdgcn_s_setprio(1); \
        _Pragma("unroll") for (int q = 0; q < 8; ++q) _Pragma("unroll") for (int r = 0; r < 4; ++r) \
            acc[r] = __builtin_amdgcn_mfma_f32_32x32x16_bf16(afr[(q - 2 * r + 6 + (SO)) % 24], bfr[q], acc[r], 0, 0, 0); \
        __builtin_amdgcn_s_setprio(0); } while (0)
#define HY_NEXT(NBASE) do { const unsigned char* ab_ = lb - (delta + 1) * 256; \
        _Pragma("unroll") for (int d = 0; d < 8; ++d) HY_FRAG(afr[(NBASE) + d], ab_, d); } while (0)
    {
        const unsigned char* ab = lb - dfirst * 256;
#pragma unroll
        for (int d = 0; d < 14; ++d) HY_FRAG(afr[d], ab, d);
    }
    for (int delta = dfirst;;) {
        HY_MMA(0); HY_NEXT(16);
        if (++delta > dlast) break;
        HY_MMA(16); HY_NEXT(8);
        if (++delta > dlast) break;
        HY_MMA(8); HY_NEXT(0);
        if (++delta > dlast) break;
    }
#undef HY_NEXT
#undef HY_MMA
#undef HY_FRAG
    if (SAMPLE) {
        __syncthreads();
        float* RED = (float*)(lds + KR_OFF);
        if (w >= 4) {
#pragma unroll
            for (int r = 0; r < 4; ++r)
#pragma unroll
                for (int i = 0; i < 16; ++i) RED[((w & 3) * 64 + r * 16 + i) * 64 + lane] = acc[r][i];
        }
        __syncthreads();
        if (w < 4) {
#pragma unroll
            for (int r = 0; r < 4; ++r)
#pragma unroll
                for (int i = 0; i < 16; ++i) acc[r][i] += RED[(w * 64 + r * 16 + i) * 64 + lane];
        }
    }
    if (!SAMPLE || w < 4) {
        const size_t tb = (size_t)c * NT + (SAMPLE ? NTP + a_n * 128 : b_n * 4096 + a_n * 128);
#pragma unroll
        for (int r = 0; r < 4; ++r)
#pragma unroll
            for (int gq = 0; gq < 4; ++gq) {
                const size_t idx = tb + 32 * r + 8 * gq + 4 * h;
                const u32x2 gv = *(const u32x2*)(Gate + idx);
                u32x2 ov; ov.x = pk2(acc[r][4 * gq] * bflo(gv.x), acc[r][4 * gq + 1] * bfhi(gv.x)); ov.y = pk2(acc[r][4 * gq + 2] * bflo(gv.y), acc[r][4 * gq + 3] * bfhi(gv.y));
                *(u32x2*)(Zout + idx) = ov;
            }
    }
    __syncthreads();
}

DI void fin_unit(KP P, int l, int unit, unsigned char* lds, int tid_) {
    const int tid = opaque_v(tid_);
    bf16_t* HB = (bf16_t*)(P->out);
    const bf16_t* Z2 = (const bf16_t*)(P->ws + WS_HY);
    const float* og = P->in[19] + l * 1024;
    const int tok0 = unit * 64;
    float* T = (float*)lds;
    const int w = tid >> 6, lane = tid & 63;
    u32x4 ra[8]; u32x2 rb[8];
#pragma unroll
    for (int rr = 0; rr < 8; ++rr) { const bf16_t* row = HB + (size_t)(tok0 + w * 8 + rr) * DM; ra[rr] = *(const u32x4*)(row + lane * 8); rb[rr] = *(const u32x2*)(row + 512 + lane * 4); }
    const f32x4 ga0 = *(const f32x4*)(og + lane * 8), ga1 = *(const f32x4*)(og + lane * 8 + 4), gb = *(const f32x4*)(og + 512 + lane * 4), gc = *(const f32x4*)(og + 768 + lane * 4);
    u32x4 zv[4];
#pragma unroll
    for (int j_ = 0; j_ < 4; ++j_) { const int item = tid + 512 * j_; zv[j_] = *(const u32x4*)(Z2 + (size_t)(item >> 3) * NT + tok0 + (item & 7) * 8); }
#pragma unroll
    for (int j_ = 0; j_ < 4; ++j_) {
        const int item = tid + 512 * j_;
        const int cc = item >> 3, q = item & 7;
        float f[8]; unpack8(zv[j_], f);
#pragma unroll
        for (int j = 0; j < 8; ++j) T[(q * 8 + j) * 257 + cc] = f[j];
    }
    __syncthreads();
#pragma unroll
    for (int rr = 0; rr < 8; ++rr) {
        const int t = w * 8 + rr; bf16_t* row = HB + (size_t)(tok0 + t) * DM;
        {
            float f[8]; unpack8(ra[rr], f); float ss = 0.f;
#pragma unroll
            for (int j = 0; j < 8; ++j) ss += f[j] * f[j];
            ss = wave_sum(ss); const float rs = __builtin_amdgcn_rsqf(ss * (1.0f / 512.0f) + EPSV);
#pragma unroll
            for (int j = 0; j < 4; ++j) { f[j] *= rs * ga0[j]; f[4 + j] *= rs * ga1[j]; }
            *(u32x4*)(row + lane * 8) = pack8(f);
        }
        {
            const u32x2 raw = rb[rr];
            float f0 = bflo(raw.x), f1 = bfhi(raw.x), f2 = bflo(raw.y), f3 = bfhi(raw.y);
            float ss = wave_sum(f0 * f0 + f1 * f1 + f2 * f2 + f3 * f3); const float rs = __builtin_amdgcn_rsqf(ss * (1.0f / 256.0f) + EPSV);
            u32x2 ov; ov.x = pk2(f0 * rs * gb[0], f1 * rs * gb[1]); ov.y = pk2(f2 * rs * gb[2], f3 * rs * gb[3]);
            *(u32x2*)(row + 512 + lane * 4) = ov;
        }
        {
            const float* tp = T + t * 257 + lane * 4;
            const float f0 = tp[0], f1 = tp[1], f2 = tp[2], f3 = tp[3];
            float ss = wave_sum(f0 * f0 + f1 * f1 + f2 * f2 + f3 * f3); const float rs = __builtin_amdgcn_rsqf(ss * (1.0f / 256.0f) + EPSV);
            u32x2 ov; ov.x = pk2(f0 * rs * gc[0], f1 * rs * gc[1]); ov.y = pk2(f2 * rs * gc[2], f3 * rs * gc[3]);
            *(u32x2*)(row + 768 + lane * 4) = ov;
        }
    }
    __syncthreads();
}

__global__ void __launch_bounds__(512, 2) mega(Params Parg) {
    extern __shared__ __attribute__((aligned(16))) unsigned char lds[];
    cg::grid_group grid = cg::this_grid();
    LAS unsigned char* ldsl = (LAS unsigned char*)lds;
    const int tid = threadIdx.x;
    KP Pk = (KP)__builtin_amdgcn_kernarg_segment_ptr();
#define PH_BEGIN() KP P = Pk; asm volatile("" : "+s"(P)); const int bid = opaque_s(blockIdx.x), G = opaque_s(gridDim.x); unsigned char* ws = P->ws; (void)ws; (void)bid; (void)G
    volatile LAS unsigned* stw = (volatile LAS unsigned*)(ldsl + LDS_BYTES - 16);
    if (tid < 4) stw[tid] = 0u;
    __syncthreads();
    const XcdBarrier xb = xcd_barrier_post((unsigned*)(Pk->ws + WS_BAR), stw);
#define GSYNC() xcd_barrier(xb)

    if constexpr ((PHM & 1) != 0) for (int rep = 0; rep < REP_P0; ++rep) {
        PH_BEGIN();
        const int par = (bid >> 3) & 1;
        for (int step = 0; step < 2; ++step) {
            if ((step == 0) == (par == 1)) {
                for (int u = bid; u < 2 * 2816 / 4; u += G) transpose_group(P, ws, u, lds, tid);
                xb_rows(P->in[0], P->in[1], (bf16_t*)(ws + WS_HB), (float*)(ws + WS_SS), tid, bid, G);
            } else {
                for (int u = bid; u < 2 * 320; u += G) {
                    const int l = u / 320, t = u % 320;
                    if (t < 256) filter_tile(P, l, 0, t, lds, tid); else filter_tile(P, l, 1, t - 256, lds, tid);
                }
                for (int idx = bid * 512 + tid; idx < 2048 * 513; idx += G * 512) {
                    const int arr = idx / 513, j = idx % 513;
                    const int kind = arr >> 10, a = arr & 1023;
                    const int Lx = kind ? 4096 : 16384, KRL = kind ? KRP_LEN : KRS_LEN;
                    bf16_t* base = (bf16_t*)(ws + (kind ? WS_KRP : WS_KRS)) + (size_t)a * KRL;
                    base[j <= 256 ? j : 2 * Lx + j - 1] = 0;
                }
            }
        }
    }
    if (Pk->ws == nullptr) grid.sync();
    GSYNC();

    for (int l = 0; l < 2; ++l) {
        if constexpr ((PHM & 2) != 0) {
            PH_BEGIN();
            pg8::Gemm g{(const bf16_t*)(ws + WS_HB), (const bf16_t*)(ws + WS_WIN) + (size_t)l * 1792 * 1024, 1024};
            pg8::StaticOrder S; S.init(NT, NIN, G, bid);
            pg8::EpiBf16 E{(bf16_t*)(ws + WS_P), NIN, (const float*)(ws + WS_SS) + (size_t)(l == 0 ? 0 : 2) * NT};
            for (int rep = 0; rep < REP_L1; ++rep) pg8::gemm_phase<pg8::EpiBf16, pg8::StaticOrder, true, 1024>(ldsl, g, S, E);
        }
        GSYNC();
        {
            PH_BEGIN();
            for (int rep = 0; rep < REP_L2; ++rep)
            for (int u = bid; u < 3 * 768; u += G) {
                if (u < 768) { if constexpr ((PHM & 4) != 0) attn_unit(P, l, u, lds, tid); }
                else if (u < 1536) { if constexpr ((PHM & 8) != 0) pool_unit(P, l, u - 768, lds, tid); }
                else { if constexpr ((PHM & 16) != 0) prep_unit(P, l, u - 1536, lds, tid); }
            }
        }
        GSYNC();
        for (int o = 0; o < 2; ++o) {
            {
                PH_BEGIN();
                bf16_t* HY = (bf16_t*)(ws + WS_HY);
                const bf16_t* Uin = o == 0 ? HY : HY + 3 * HY_ARR;
                const bf16_t* Gt = HY + (size_t)(1 + o) * HY_ARR;
                bf16_t* Zo = o == 0 ? HY + 3 * HY_ARR : HY;
                for (int rep = 0; rep < REP_HY; ++rep)
                for (int u = bid; u < 512; u += G) {
                    const int c = u & 255;
                    if constexpr ((PHM & 32) != 0) { if (u < 256) hyena_unit<true>(Uin, Gt, Zo, (const bf16_t*)(ws + WS_KRS) + (size_t)((l * 2 + o) * 256 + c) * KRS_LEN, c, lds, tid);
                    else hyena_unit<false>(Uin, Gt, Zo, (const bf16_t*)(ws + WS_KRP) + (size_t)((l * 2 + o) * 256 + c) * KRP_LEN, c, lds, tid); }
                }
            }
            GSYNC();
        }
        if constexpr ((PHM & 64) != 0) { PH_BEGIN(); for (int u = bid; u < 768; u += G) fin_unit(P, l, u, lds, tid); }
        GSYNC();
        if constexpr ((PHM & 128) != 0) {
            PH_BEGIN();
            pg8::Gemm g{(const bf16_t*)(P->out), (const bf16_t*)(ws + WS_WOUT) + (size_t)l * 1024 * 1024, 1024};
            pg8::StaticOrder S; S.init(NT, DM, G, bid);
            pg8::EpiResid<false> E{(bf16_t*)(ws + WS_HB), (float*)(ws + WS_SS) + (size_t)(l == 0 ? 1 : 3) * NT, nullptr};
            pg8::gemm_phase<pg8::EpiResid<false>, pg8::StaticOrder, true, 1024>(ldsl, g, S, E);
        }
        GSYNC();
        if constexpr ((PHM & 256) != 0) {
            PH_BEGIN();
            pg8::Gemm g{(const bf16_t*)(ws + WS_HB), (const bf16_t*)(ws + WS_WF1) + (size_t)l * 5632 * 1024, 1024};
            pg8::FfnOrder S; S.G = G; S.vb = (G % 8 == 0) ? (bid % 8) * (G / 8) + bid / 8 : bid;
            pg8::EpiFfnReg E{(bf16_t*)(ws + WS_ACT), P->in[23] + (size_t)l * 3 * NFF2, P->in[24] + (size_t)l * NFF2, (const float*)(ws + WS_SS) + (size_t)(l == 0 ? 1 : 3) * NT};
            for (int rep = 0; rep < REP_FFN; ++rep) pg8::gemm_phase<pg8::EpiFfnReg, pg8::FfnOrder, true, 1024, 62>(ldsl, g, S, E);
        }
        GSYNC();
        if constexpr ((PHM & 512) != 0) {
            PH_BEGIN();
            pg8::Gemm g{(const bf16_t*)(ws + WS_ACT), (const bf16_t*)(ws + WS_WF2) + (size_t)l * 1024 * 2816, 2816};
            pg8::StaticOrder S; S.init(NT, DM, G, bid);
            if (l == 0) {
                pg8::EpiResid<false> E{(bf16_t*)(ws + WS_HB), (float*)(ws + WS_SS) + (size_t)2 * NT, nullptr};
                pg8::gemm_phase<pg8::EpiResid<false>, pg8::StaticOrder, true, 2816>(ldsl, g, S, E);
            } else {
                pg8::EpiResid<true> E{(bf16_t*)(ws + WS_HB), nullptr, P->out};
                pg8::gemm_phase<pg8::EpiResid<true>, pg8::StaticOrder, true, 2816>(ldsl, g, S, E);
            }
        }
        if (l == 0) GSYNC();
    }
}

extern "C" void kernel_launch(void* const* d_in, const int* in_sizes, int n_in, void* d_out, int out_size, void* d_ws, size_t ws_size, hipStream_t stream) {
    static int grid = 0;
    if (grid == 0) {
        if (n_in != 26 || ws_size < WS_END) { fprintf(stderr, "kernel_launch: need 26 inputs and %zu bytes of workspace (got %d, %zu)\n", (size_t)WS_END, n_in, ws_size); grid = -1; return; }
        int dev = 0, cus = 0, per_cu = 0;
        hipGetDevice(&dev);
        hipDeviceGetAttribute(&cus, hipDeviceAttributeMultiprocessorCount, dev);
        if (hipFuncSetAttribute((const void*)mega, hipFuncAttributeMaxDynamicSharedMemorySize, LDS_BYTES) != hipSuccess) { fprintf(stderr, "kernel_launch: hipFuncSetAttribute failed\n"); grid = -1; return; }
        hipOccupancyMaxActiveBlocksPerMultiprocessor(&per_cu, (const void*)mega, 512, LDS_BYTES);
        if (per_cu < 1) { fprintf(stderr, "kernel_launch: occupancy query says %d blocks per CU\n", per_cu); per_cu = 1; }
        (void)hipGetLastError();
        grid = cus * 1;
    }
    if (grid < 0) return;
    Params p{};
    for (int i = 0; i < 26; ++i) p.in[i] = (const float*)d_in[i];
    p.out = (float*)d_out; p.ws = (unsigned char*)d_ws;
    if (hipMemsetAsync((char*)d_ws + WS_BAR, 0, 16384, stream) != hipSuccess) { fprintf(stderr, "memset failed\n"); return; }
    void* args[] = {&p};
    hipError_t e = hipLaunchCooperativeKernel((const void*)mega, dim3(grid), dim3(512), args, LDS_BYTES, stream);
    if (e != hipSuccess) fprintf(stderr, "cooperative launch failed: %s (grid %d)\n", hipGetErrorString(e), grid);
}
```

```cpp
#include <hip/hip_runtime.h>
#include <hip/hip_cooperative_groups.h>
#include <cstdio>
#include <cstdint>
namespace cg = cooperative_groups;

#define DI __device__ __forceinline__
#define LAS __attribute__((address_space(3)))
typedef unsigned short bf16_t;
typedef short bf16x8 __attribute__((ext_vector_type(8)));
typedef float f32x4 __attribute__((ext_vector_type(4)));
typedef float f32x16 __attribute__((ext_vector_type(16)));
typedef float f32x2 __attribute__((ext_vector_type(2)));
typedef unsigned u32x4 __attribute__((ext_vector_type(4)));
typedef unsigned u32x2 __attribute__((ext_vector_type(2)));
typedef __bf16 bf16x2n __attribute__((ext_vector_type(2)));

constexpr int NT = 49152, NTP = 32768, DM = 1024, NIN = 1792, DFF = 2816, NFF2 = 5632;
constexpr int LDS_BYTES = 147456;
#ifndef PHM
#define PHM 0xFFFF
#endif
#ifndef REP_FFN
#define REP_FFN 1
#endif
#ifndef REP_HY
#define REP_HY 1
#endif
#ifndef REP_L1
#define REP_L1 1
#endif
#ifndef REP_L2
#define REP_L2 1
#endif
#ifndef REP_P0
#define REP_P0 1
#endif
constexpr float EPSV = 1e-6f;
constexpr float LOG2E = 1.4426950408889634f;

constexpr size_t WS_WIN = 0;
constexpr size_t WS_WOUT = WS_WIN + 2ull * 1792 * 1024 * 2;
constexpr size_t WS_WF1 = WS_WOUT + 2ull * 1024 * 1024 * 2;
constexpr size_t WS_WF2 = WS_WF1 + 2ull * 5632 * 1024 * 2;
constexpr size_t WS_HB = WS_WF2 + 2ull * 1024 * 2816 * 2;
constexpr int KRS_LEN = 2 * 16384 + 512, KRP_LEN = 2 * 4096 + 512, KR_PAD = 256;
constexpr size_t WS_KRS = WS_HB + (size_t)NT * 1024 * 2;
constexpr size_t WS_KRP = WS_KRS + 4ull * 256 * KRS_LEN * 2;
constexpr size_t WS_P = WS_KRP + 4ull * 256 * KRP_LEN * 2;
constexpr size_t WS_HY = WS_P + (size_t)NT * 1792 * 2;
constexpr size_t HY_ARR = (size_t)256 * NT;
constexpr size_t WS_ACT = WS_P;
constexpr size_t WS_BAR = WS_HY + 4 * HY_ARR * 2;
constexpr size_t WS_SS = WS_BAR + 16384;
constexpr size_t WS_END = WS_SS + 4ull * NT * 4;
static_assert(WS_ACT + (size_t)NT * 2816 * 2 <= WS_BAR, "act alias");

struct Params { const float* in[26]; float* out; unsigned char* ws; };
typedef const __attribute__((address_space(4))) Params* KP;

DI unsigned pk2(float lo, float hi) { f32x2 v = {lo, hi}; return __builtin_bit_cast(unsigned, __builtin_convertvector(v, bf16x2n)); }
DI float bflo(unsigned u) { return __uint_as_float(u << 16); }
DI float bfhi(unsigned u) { return __uint_as_float(u & 0xffff0000u); }
DI float bf2f(bf16_t v) { return __uint_as_float(((unsigned)v) << 16); }
DI bf16_t f2bf(float x) { return (bf16_t)(pk2(x, 0.f) & 0xffffu); }
DI void unpack8(const u32x4& r, float (&f)[8]) {
    f[0] = bflo(r.x); f[1] = bfhi(r.x); f[2] = bflo(r.y); f[3] = bfhi(r.y); f[4] = bflo(r.z); f[5] = bfhi(r.z); f[6] = bflo(r.w); f[7] = bfhi(r.w);
}
DI u32x4 pack8(const float (&f)[8]) { u32x4 w; w.x = pk2(f[0], f[1]); w.y = pk2(f[2], f[3]); w.z = pk2(f[4], f[5]); w.w = pk2(f[6], f[7]); return w; }
DI void seq_info(int tok, int& s0, int& L) { if (tok < NTP) { s0 = tok & ~4095; L = 4096; } else { s0 = NTP; L = 16384; } }
DI float wave_sum(float v) {
#pragma unroll
    for (int o = 1; o < 64; o <<= 1) v += __shfl_xor(v, o);
    return v;
}
DI float sin_rev(float rev) { return __builtin_amdgcn_sinf(__builtin_amdgcn_fractf(rev)); }
DI float cos_rev(float rev) { return __builtin_amdgcn_cosf(__builtin_amdgcn_fractf(rev)); }
DI float sin_rad(float x) { return sin_rev(x * 0.15915494309189535f); }
DI int opaque_v(int x) { asm volatile("" : "+v"(x)); return x; }
DI int opaque_s(int x) { asm volatile("" : "+s"(x)); return x; }
DI float gelu_f(float v) {
    const float av = fabsf(v), t = __builtin_amdgcn_rcpf(av * 0.2316418882f + 1.0f);
    float q = t * 0.5307027145f + (-0.7265760135f); q = q * t + 0.7107068705f; q = q * t + (-0.142248368f); q = q * t + 0.127414796f; q = q * t;
    const float e = __builtin_amdgcn_exp2f((v * v) * (-0.72134752044f));
    const float m = v * (q * e);
    return v < 0.f ? m : v - m;
}
DI int crow(int reg, int h) { return (reg & 3) + 8 * (reg >> 2) + 4 * h; }

namespace pg8 {
constexpr int BM = 256, BK = 64, HALF = 128, HTB = HALF * BK * 2, NXCD = 8, WGM = 8;
DI int lds_byte(int r, int c) { const int st = (r >> 4) * 2 + (c >> 5), rr = r & 15, cc = c & 31, ob = rr * 64 + cc * 2; return st * 1024 + (ob ^ (((ob >> 9) & 1) << 5)); }
DI void stage_rc(int b, int& R, int& C) { const int st = b / 1024, sb = b % 1024, swz = sb ^ (((sb >> 9) & 1) << 5); R = (st >> 1) * 16 + swz / 64; C = (st & 1) * 32 + (swz % 64) / 2; }
DI int perm32(int rho) { const int n = rho >> 4, i = rho & 15; return 8 * (i >> 2) + 4 * n + (i & 3); }

struct Unit { int pm, pn, arow; };
struct Gemm { const bf16_t* A; const bf16_t* Bt; int K; };

struct StaticOrder {
    int nM, nN, nwg, G, c;
    DI void init(int M, int N, int G_, int c_) { nM = M / BM; nN = N / BM; nwg = nM * nN; G = G_; c = c_; }
    DI bool next(int i, Unit& u) const {
        const long Lx = (long)i * G + c; if (Lx >= nwg) return false;
        int wgid = (int)Lx; { const int q = nwg / NXCD, r = nwg % NXCD, xcd = wgid % NXCD, off = wgid / NXCD; wgid = (xcd < r ? xcd * (q + 1) : r * (q + 1) + (xcd - r) * q) + off; }
        const int nig = WGM * nN, gid = wgid / nig, fm = gid * WGM, gsz = (nM - fm) < WGM ? (nM - fm) : WGM;
        u.pm = fm + ((wgid % nig) % gsz); u.pn = (wgid % nig) / gsz; u.arow = u.pm * BM; return true;
    }
};
struct OneUnit {
    Unit u;
    DI bool next(int i, Unit& o) const { if (i != 0) return false; o = u; return true; }
};

struct EpiBf16 {
    static constexpr bool AFTER_DRAIN = false, PREFETCH = false;
    bf16_t* O; int ldc; const float* ss;
    DI void operator()(const f32x4 (&acc)[2][2][4][2], const Unit& u, int wr, int wc, int fr, int fq) const {
        const int row0 = u.pm * BM + wr * 64 + fr, col0 = u.pn * BM + wc * 32 + 8 * fq;
#pragma unroll
        for (int ai = 0; ai < 2; ++ai)
#pragma unroll
            for (int m = 0; m < 4; ++m) {
                const int row = row0 + ai * HALF + m * 16;
                const float rs = rsqrtf(ss[row] * (1.0f / 1024.0f) + EPSV);
                bf16_t* rowp = O + (size_t)row * ldc + col0;
#pragma unroll
                for (int bj = 0; bj < 2; ++bj) {
                    const f32x4 v0 = acc[ai][bj][m][0] * rs, v1 = acc[ai][bj][m][1] * rs;
                    u32x4 w; w.x = pk2(v0[0], v0[1]); w.y = pk2(v0[2], v0[3]); w.z = pk2(v1[0], v1[1]); w.w = pk2(v1[2], v1[3]);
                    *(u32x4*)(rowp + bj * HALF) = w;
                }
            }
    }
    DI void fused(const f32x4 (&)[2][2][4][2], const Unit&, int, int, int, int, LAS unsigned char*, int) const {}
};
template <bool FINAL>
struct EpiResid {
    static constexpr bool AFTER_DRAIN = false, PREFETCH = false;
    bf16_t* XB; float* ss; float* out;
    DI void operator()(const f32x4 (&acc)[2][2][4][2], const Unit& u, int wr, int wc, int fr, int fq) const {
        const int row0 = u.pm * BM + wr * 64 + fr, col0 = u.pn * BM + wc * 32 + 8 * fq;
#pragma unroll
        for (int ai = 0; ai < 2; ++ai)
#pragma unroll
            for (int m = 0; m < 4; ++m) {
                const int row = row0 + ai * HALF + m * 16;
                bf16_t* xp = XB + (size_t)row * DM + col0;
                float sq = 0.f;
#pragma unroll
                for (int bj = 0; bj < 2; ++bj) {
                    const u32x4 r = *(const u32x4*)(xp + bj * HALF);
                    float f[8]; unpack8(r, f);
                    const f32x4 a0 = acc[ai][bj][m][0], a1 = acc[ai][bj][m][1];
                    f[0] += a0[0]; f[1] += a0[1]; f[2] += a0[2]; f[3] += a0[3]; f[4] += a1[0]; f[5] += a1[1]; f[6] += a1[2]; f[7] += a1[3];
                    if (FINAL) {
                        float* op = out + (size_t)row * DM + col0 + bj * HALF;
                        __builtin_nontemporal_store((f32x4){f[0], f[1], f[2], f[3]}, (f32x4*)op); __builtin_nontemporal_store((f32x4){f[4], f[5], f[6], f[7]}, (f32x4*)(op + 4));
                    } else {
#pragma unroll
                        for (int j = 0; j < 8; ++j) sq += f[j] * f[j];
                        *(u32x4*)(xp + bj * HALF) = pack8(f);
                    }
                }
                if (!FINAL) {
                    sq += __shfl_xor(sq, 16); sq += __shfl_xor(sq, 32);
                    if (fq == 0) atomicAdd(ss + row, sq);
                }
            }
    }
    DI void fused(const f32x4 (&)[2][2][4][2], const Unit&, int, int, int, int, LAS unsigned char*, int) const {}
};
struct EpiFfn {
    static constexpr bool AFTER_DRAIN = true, PREFETCH = false;
    bf16_t* act; const float* cw; const float* cb; int tok0, jlo, jhi;
    DI void operator()(const f32x4 (&)[2][2][4][2], const Unit&, int, int, int, int) const {}
    DI void fused(const f32x4 (&acc)[2][2][4][2], const Unit& u, int wr, int wc, int fr, int fq, LAS unsigned char* lds, int tid) const {
        constexpr int TS = 528;
#pragma unroll
        for (int ai = 0; ai < 2; ++ai)
#pragma unroll
            for (int m = 0; m < 4; ++m) {
                const int row = ai * HALF + wr * 64 + m * 16 + fr;
#pragma unroll
                for (int bj = 0; bj < 2; ++bj) {
                    const f32x4 v0 = acc[ai][bj][m][0], v1 = acc[ai][bj][m][1];
                    u32x4 w; w.x = pk2(v0[0], v0[1]); w.y = pk2(v0[2], v0[3]); w.z = pk2(v1[0], v1[1]); w.w = pk2(v1[2], v1[3]);
                    *(LAS u32x4*)(lds + row * TS + (bj * HALF + wc * 32 + 8 * fq) * 2) = w;
                }
            }
        __syncthreads();
        const int c8 = (tid & 15) * 8, rg = tid >> 4;
        const int gcol = u.pn * 128 + c8, ucol = DFF + gcol;
        float wg[3][8], wu[3][8], bg[8], bu[8];
#pragma unroll
        for (int k = 0; k < 3; ++k)
#pragma unroll
            for (int j = 0; j < 8; ++j) { wg[k][j] = cw[k * NFF2 + gcol + j]; wu[k][j] = cw[k * NFF2 + ucol + j]; }
#pragma unroll
        for (int j = 0; j < 8; ++j) { bg[j] = cb[gcol + j]; bu[j] = cb[ucol + j]; }
        float pg[8], pu[8], cg_[8], cu[8], ng[8], nu[8];
        const int r0 = rg * 8;
        {
            u32x4 a = {0, 0, 0, 0}, b = {0, 0, 0, 0};
            if (r0 > 0) { a = *(const LAS u32x4*)(lds + (r0 - 1) * TS + c8 * 2); b = *(const LAS u32x4*)(lds + (r0 - 1) * TS + (128 + c8) * 2); }
            unpack8(a, pg); unpack8(b, pu);
            a = *(const LAS u32x4*)(lds + r0 * TS + c8 * 2); b = *(const LAS u32x4*)(lds + r0 * TS + (128 + c8) * 2);
            unpack8(a, cg_); unpack8(b, cu);
        }
#pragma unroll
        for (int i = 0; i < 8; ++i) {
            const int r = r0 + i;
            u32x4 a = {0, 0, 0, 0}, b = {0, 0, 0, 0};
            if (r < 255) { a = *(const LAS u32x4*)(lds + (r + 1) * TS + c8 * 2); b = *(const LAS u32x4*)(lds + (r + 1) * TS + (128 + c8) * 2); }
            unpack8(a, ng); unpack8(b, nu);
            if (r >= jlo && r <= jhi) {
                float o[8];
#pragma unroll
                for (int j = 0; j < 8; ++j) {
                    const float g = pg[j] * wg[0][j] + cg_[j] * wg[1][j] + ng[j] * wg[2][j] + bg[j];
                    const float up = pu[j] * wu[0][j] + cu[j] * wu[1][j] + nu[j] * wu[2][j] + bu[j];
                    o[j] = gelu_f(g) * up;
                }
                *(u32x4*)(act + (size_t)(tok0 + r) * DFF + gcol) = pack8(o);
            }
#pragma unroll
            for (int j = 0; j < 8; ++j) { pg[j] = cg_[j]; pu[j] = cu[j]; cg_[j] = ng[j]; cu[j] = nu[j]; }
        }
        __syncthreads();
    }
};

constexpr int FFN_MT = 136 + 67, FFN_UNITS = FFN_MT * 22;
DI void ffn_decode(int mt, int& s0, int& L, int& ti) { if (mt < 136) { s0 = (mt / 17) * 4096; ti = mt % 17; L = 4096; } else { s0 = NTP; ti = mt - 136; L = 16384; } }
struct FfnOrder {
    int G, vb;
    DI bool next(int i, Unit& u) const {
        const int t = i * G + vb; if (t >= FFN_UNITS) return false;
        int mt, pn;
        constexpr int BS = 6, NFULL = 22 / BS, REM = 22 - NFULL * BS;
        if (t < NFULL * BS * FFN_MT) { const int blk = t / (BS * FFN_MT), r = t % (BS * FFN_MT); mt = r / BS; pn = blk * BS + r % BS; }
        else { const int r = t - NFULL * BS * FFN_MT; mt = r / REM; pn = NFULL * BS + r % REM; }
        int s0, L, ti; ffn_decode(mt, s0, L, ti);
        u.pm = mt; u.pn = pn; u.arow = s0 + 248 * ti - 1; return true;
    }
};
DI f32x4 dpp_rot(const f32x4& v, bool one) {
    f32x4 r;
#pragma unroll
    for (int j = 0; j < 4; ++j) {
        const int x = __float_as_int(v[j]);
        r[j] = __int_as_float(one ? __builtin_amdgcn_update_dpp(0, x, 0x121, 0xf, 0xf, true) : __builtin_amdgcn_update_dpp(0, x, 0x12F, 0xf, 0xf, true));
    }
    return r;
}
DI f32x4 sel4(bool c, const f32x4& a, const f32x4& b) { f32x4 r; r[0] = c ? a[0] : b[0]; r[1] = c ? a[1] : b[1]; r[2] = c ? a[2] : b[2]; r[3] = c ? a[3] : b[3]; return r; }
struct EpiFfnReg {
    static constexpr bool AFTER_DRAIN = false, PREFETCH = true;
    static constexpr int XOFF = 131072;
    bf16_t* act; const float* cw; const float* cb; const float* ss;
    DI void prefetch(const Unit& u, LAS unsigned char* lds, int wid, int lane, int buf) const {
        if (wid < 4) {
            const int a = 2 * wid + (lane >> 5), k = a & 3;
            const float* src = (k < 3 ? cw + (size_t)k * NFF2 : cb) + (a >= 4 ? DFF : 0) + u.pn * 128 + (lane & 31) * 4;
            __builtin_amdgcn_global_load_lds((const unsigned*)src, (LAS unsigned*)(lds + XOFF + buf * 4096 + wid * 1024), 16, 0, 0);
        } else if (wid == 4) {
            int s0, L, ti; ffn_decode(u.pm, s0, L, ti);
            const int start = (s0 + 248 * ti - 1) & ~3;
            __builtin_amdgcn_global_load_lds((const unsigned*)(ss + start + lane * 4), (LAS unsigned*)(lds + XOFF + 8192 + buf * 1024), 16, 0, 0);
        }
    }
    DI void operator()(const f32x4 (&)[2][2][4][2], const Unit&, int, int, int, int) const {}
    DI void run(const f32x4 (&acc)[2][2][4][2], const Unit& u, int wr, int wc, int fr, int fq, LAS unsigned char* lds, int buf) const {
        int s0, L, ti; ffn_decode(u.pm, s0, L, ti);
        const LAS float* wl = (const LAS float*)(lds + XOFF + buf * 4096);
        const LAS float* sl = (const LAS float*)(lds + XOFF + 8192 + buf * 1024) - ((s0 + 248 * ti - 1) & ~3);
        float rsv[2][4];
#pragma unroll
        for (int ai = 0; ai < 2; ++ai)
#pragma unroll
            for (int m = 0; m < 4; ++m) { int p_ = 248 * ti + 62 * (2 * ai + wr) - 1 + 16 * m + fr; p_ = p_ < 0 ? 0 : (p_ > L - 1 ? L - 1 : p_); rsv[ai][m] = __builtin_amdgcn_rsqf(sl[s0 + p_] * (1.0f / 1024.0f) + EPSV); }
        const int gcol = u.pn * 128 + wc * 32 + 8 * fq;
        const bool is15 = (fr == 15), is0 = (fr == 0);
#pragma unroll
        for (int n = 0; n < 2; ++n) {
            const int gc = gcol + 4 * n, lc = wc * 32 + 8 * fq + 4 * n;
            const f32x4 wg0 = *(const LAS f32x4*)(wl + lc), wg1 = *(const LAS f32x4*)(wl + 128 + lc), wg2 = *(const LAS f32x4*)(wl + 256 + lc), bgv = *(const LAS f32x4*)(wl + 384 + lc);
            const f32x4 wu0 = *(const LAS f32x4*)(wl + 512 + lc), wu1 = *(const LAS f32x4*)(wl + 640 + lc), wu2 = *(const LAS f32x4*)(wl + 768 + lc), buv = *(const LAS f32x4*)(wl + 896 + lc);
#pragma unroll
            for (int ai = 0; ai < 2; ++ai) {
                const int posb = 248 * ti + 62 * (2 * ai + wr) - 1;
                f32x4 sg[4], su[4];
#pragma unroll
                for (int m = 0; m < 4; ++m) { sg[m] = acc[ai][0][m][n] * rsv[ai][m]; su[m] = acc[ai][1][m][n] * rsv[ai][m]; }
#pragma unroll
                for (int m = 0; m < 4; ++m) {
                    const int rho = 16 * m + fr, pos = posb + rho;
                    const f32x4 xg = sg[m], xu = su[m];
                    const f32x4 zpg = (m > 0) ? sel4(is15, sg[m > 0 ? m - 1 : 0], xg) : xg;
                    const f32x4 zpu = (m > 0) ? sel4(is15, su[m > 0 ? m - 1 : 0], xu) : xu;
                    const f32x4 zng = (m < 3) ? sel4(is0, sg[m < 3 ? m + 1 : 3], xg) : xg;
                    const f32x4 znu = (m < 3) ? sel4(is0, su[m < 3 ? m + 1 : 3], xu) : xu;
                    const f32x4 pg = dpp_rot(zpg, true), pu = dpp_rot(zpu, true), ng = dpp_rot(zng, false), nu = dpp_rot(znu, false);
                    f32x4 g = pg * wg0 + xg * wg1 + ng * wg2 + bgv;
                    f32x4 up = pu * wu0 + xu * wu1 + nu * wu2 + buv;
                    if (posb + 16 * m <= 0 && posb + 16 * m + 15 >= 0) { if (pos == 0) { g = xg * wg1 + ng * wg2 + bgv; up = xu * wu1 + nu * wu2 + buv; } }
                    if (posb + 16 * m <= L - 1 && posb + 16 * m + 15 >= L - 1) { if (pos == L - 1) { g = g - ng * wg2; up = up - nu * wu2; } }
                    if (rho >= 1 && rho <= 62 && pos < L) {
                        u32x2 ov; ov.x = pk2(gelu_f(g[0]) * up[0], gelu_f(g[1]) * up[1]); ov.y = pk2(gelu_f(g[2]) * up[2], gelu_f(g[3]) * up[3]);
                        *(u32x2*)(act + (size_t)(s0 + pos) * DFF + gc) = ov;
                    }
                }
            }
        }
    }
    DI void fused(const f32x4 (&)[2][2][4][2], const Unit&, int, int, int, int, LAS unsigned char*, int) const {}
};

template <class Epi, class Sched, bool ALIGN_EPI, int KDIM, int SEG = 64>
DI void gemm_phase(LAS unsigned char* lds, const Gemm g, const Sched& S, const Epi& E) {
    const int tid = opaque_v(threadIdx.x), wid = __builtin_amdgcn_readfirstlane(tid >> 6), lane = tid & 63, wr = wid >> 2, wc = wid & 3, fr = lane & 15, fq = lane >> 4;
    constexpr int K = KDIM, nt = K / BK;
    unsigned voffA[2], voffB[2];
#pragma unroll
    for (int i = 0; i < 2; ++i) { int R, C; stage_rc(tid * 16 + i * 8192, R, C); const int Rb = (R & ~31) + perm32(R & 31);
        voffA[i] = (unsigned)((SEG * (R >> 6) + (R & 63)) * K + C) * 2u; voffB[i] = (unsigned)(Rb * K + C) * 2u; }
    constexpr size_t kstep = (size_t)(BK * 2);
    constexpr size_t hstep = (size_t)HALF * K * 2;
    constexpr size_t hstepA = (size_t)(2 * SEG) * K * 2;
    constexpr size_t tstep = 2 * hstep;
    constexpr size_t rstep = (size_t)K * 2;
    const unsigned ldsw = (unsigned)wid * 1024u;
    const int aoff = lds_byte(wr * 64 + fr, fq * 8), boff = lds_byte(wc * 32 + fr, fq * 8);
#define G_SA(b, h) (((b) * 2 + (h)) * HTB)
#define G_SB(b, h) ((4 + (b) * 2 + (h)) * HTB)
#define G_STAGE(bufoff, gbase, voff) do { _Pragma("unroll") for (int _i = 0; _i < 2; ++_i) \
        __builtin_amdgcn_global_load_lds((const unsigned*)((const char*)(gbase) + (voff)[_i]), (LAS unsigned*)(lds + (bufoff) + ldsw + _i * 8192), 16, 0, 0); } while (0)
#define G_LDA(dst, b, h) do { _Pragma("unroll") for (int m = 0; m < 4; ++m) _Pragma("unroll") for (int k = 0; k < 2; ++k) dst[m][k] = *(const LAS bf16x8*)(lds + G_SA(b, h) + aoff + m * 2048 + k * 1024); } while (0)
#define G_LDB(dst, b, h) do { _Pragma("unroll") for (int n = 0; n < 2; ++n) _Pragma("unroll") for (int k = 0; k < 2; ++k) dst[n][k] = *(const LAS bf16x8*)(lds + G_SB(b, h) + boff + n * 2048 + k * 1024); } while (0)
#define G_MMA(ai, bj, At, Bt) do { __builtin_amdgcn_s_setprio(1); _Pragma("unroll") for (int m = 0; m < 4; ++m) _Pragma("unroll") for (int n = 0; n < 2; ++n) _Pragma("unroll") for (int k = 0; k < 2; ++k) \
        acc[ai][bj][m][n] = __builtin_amdgcn_mfma_f32_16x16x32_bf16(Bt[n][k], At[m][k], acc[ai][bj][m][n], 0, 0, 0); __builtin_amdgcn_s_setprio(0); } while (0)
#define G_WAIT_V(n) asm volatile("s_waitcnt vmcnt(" #n ")" ::: "memory")
#define G_WAIT_L(n) asm volatile("s_waitcnt lgkmcnt(" #n ")" ::: "memory")
#define G_BAR __builtin_amdgcn_s_barrier()
#define G_SCHED __builtin_amdgcn_sched_barrier(0)
    Unit cur, nxt; int ui = 0;
    if (!S.next(0, cur)) return;
    f32x4 acc[2][2][4][2];
#pragma unroll
    for (int a = 0; a < 2; ++a)
#pragma unroll
        for (int b = 0; b < 2; ++b)
#pragma unroll
            for (int m = 0; m < 4; ++m)
#pragma unroll
                for (int n = 0; n < 2; ++n) acc[a][b][m][n] = (f32x4){0.f, 0.f, 0.f, 0.f};
    bf16x8 At[4][2], B0[2][2], B1[2][2];
    const char* cA = (const char*)g.A + (size_t)cur.arow * rstep; const char* cB = (const char*)g.Bt + (size_t)cur.pn * tstep;
    if constexpr (Epi::PREFETCH) E.prefetch(cur, lds, wid, lane, 0);
    G_STAGE(G_SB(0, 0), cB, voffB); G_STAGE(G_SB(0, 1), cB + hstep, voffB); G_STAGE(G_SA(0, 0), cA, voffA); G_STAGE(G_SA(0, 1), cA + hstepA, voffA);
    if (wr == 1) G_BAR;
    G_WAIT_V(2); G_BAR;
    G_STAGE(G_SB(1, 0), cB + kstep, voffB); G_STAGE(G_SA(1, 0), cA + kstep, voffA); G_STAGE(G_SB(1, 1), cB + hstep + kstep, voffB);
    G_WAIT_V(6); G_BAR;
    for (;;) {
        const bool has_next = S.next(ui + 1, nxt);
        const char* nA = has_next ? (const char*)g.A + (size_t)nxt.arow * rstep : cA; const char* nB = has_next ? (const char*)g.Bt + (size_t)nxt.pn * tstep : cB;
        for (int t = 0; t < nt; t += 2) {
            const bool last = (t == nt - 2);
            const char* a1 = cA + (size_t)(t + 1) * kstep;
            const char* a2 = last ? nA : cA + (size_t)(t + 2) * kstep; const char* b2 = last ? nB : cB + (size_t)(t + 2) * kstep;
            const char* a3 = a2 + kstep; const char* b3 = b2 + kstep;
            G_LDB(B0, 0, 0); G_LDB(B1, 0, 1); G_SCHED; G_LDA(At, 0, 0); G_STAGE(G_SA(1, 1), a1 + hstepA, voffA);
            G_WAIT_V(8); G_WAIT_L(0); G_BAR; G_MMA(0, 0, At, B0); G_MMA(0, 1, At, B1); G_BAR; G_SCHED;
            G_LDA(At, 0, 1); G_STAGE(G_SB(0, 0), b2, voffB); G_STAGE(G_SB(0, 1), b2 + hstep, voffB); G_STAGE(G_SA(0, 0), a2, voffA);
            G_WAIT_V(8); G_WAIT_L(0); G_BAR; G_MMA(1, 0, At, B0); G_MMA(1, 1, At, B1); G_BAR; G_SCHED;
            G_LDB(B0, 1, 0); G_LDB(B1, 1, 1); G_SCHED; G_LDA(At, 1, 0); G_STAGE(G_SA(0, 1), a2 + hstepA, voffA);
            G_WAIT_V(8); G_WAIT_L(0); G_BAR; G_MMA(0, 0, At, B0); G_MMA(0, 1, At, B1); G_BAR; G_SCHED;
            G_LDA(At, 1, 1); G_STAGE(G_SB(1, 0), b3, voffB); G_STAGE(G_SB(1, 1), b3 + hstep, voffB); G_STAGE(G_SA(1, 0), a3, voffA);
            G_WAIT_V(8); G_WAIT_L(0); G_BAR; G_MMA(1, 0, At, B0); G_MMA(1, 1, At, B1); G_BAR; G_SCHED;
        }
        if constexpr (ALIGN_EPI) { if (wr == 0) G_BAR; }
        if constexpr (!Epi::AFTER_DRAIN) { if constexpr (Epi::PREFETCH) { E.run(acc, cur, wr, wc, fr, fq, lds, ui & 1); if (has_next) E.prefetch(nxt, lds, wid, lane, (ui + 1) & 1); } else E(acc, cur, wr, wc, fr, fq); }
        if (!has_next) break;
#pragma unroll
        for (int a = 0; a < 2; ++a)
#pragma unroll
            for (int b = 0; b < 2; ++b)
#pragma unroll
                for (int m = 0; m < 4; ++m)
#pragma unroll
                    for (int n = 0; n < 2; ++n) acc[a][b][m][n] = (f32x4){0.f, 0.f, 0.f, 0.f};
        cur = nxt; cA = nA; cB = nB; ++ui;
        if constexpr (ALIGN_EPI) { if (wr == 1) G_BAR; }
    }
    G_WAIT_V(0);
    if constexpr (!ALIGN_EPI) { if (wr == 0) G_BAR; }
    G_BAR;
    if constexpr (Epi::AFTER_DRAIN) { E.fused(acc, cur, wr, wc, fr, fq, lds, tid); }
#undef G_SA
#undef G_SB
#undef G_STAGE
#undef G_LDA
#undef G_LDB
#undef G_MMA
#undef G_WAIT_V
#undef G_WAIT_L
#undef G_BAR
#undef G_SCHED
}
}


#define XB_TMO      128
#define XB_XCNT(j)  (256  + 64 * (j))
#define XB_XSUB(j)  (1280 + 64 * (j))
#define XB_XGEN(j)  (2304 + 64 * (j))
#define XB_TOP      3328
#define XB_TOPGEN   3392
#define XCD_BAR_WORDS 3456
#define XB_SPIN_CAP (1u << 18)
DI unsigned xb_ld(unsigned* p)              { return __hip_atomic_load(p, __ATOMIC_RELAXED, __HIP_MEMORY_SCOPE_AGENT); }
DI unsigned xb_add(unsigned* p, unsigned v) { return __hip_atomic_fetch_add(p, v, __ATOMIC_RELAXED, __HIP_MEMORY_SCOPE_AGENT); }
DI unsigned xb_xcc_id() { return (unsigned)__builtin_amdgcn_s_getreg((3 << 11) | 20) & 0xFu; }
#define XB_SPIN(cond, bar) do { unsigned _sp = 0; while (cond) { __builtin_amdgcn_s_sleep(1); \
    if ((++_sp & 255u) == 0u) { if (xb_ld(&(bar)[XB_TMO])) break; if (_sp > XB_SPIN_CAP) { atomicAdd(&(bar)[XB_TMO], 1u); break; } } } } while (0)
struct XcdBarrier { unsigned* bar; unsigned x; volatile LAS unsigned* st; };
DI XcdBarrier xcd_barrier_post(unsigned* bar, volatile LAS unsigned* st) {
    XcdBarrier b; b.bar = bar; b.x = xb_xcc_id(); b.st = st;
    if (threadIdx.x == 0) (void)xb_add(&bar[XB_XCNT(b.x)], 1u);
    return b;
}
DI void xcd_barrier_complete(unsigned* bar, unsigned x, unsigned& nloc, unsigned& nx) {
    const unsigned G = gridDim.x * gridDim.y * gridDim.z;
    unsigned sum, cnt, mine, sp = 0u;
    for (;;) {
        sum = 0u; cnt = 0u; mine = 0u;
#pragma unroll
        for (unsigned j = 0; j < 16; ++j) { const unsigned c = xb_ld(&bar[XB_XCNT(j)]); sum += c; cnt += (c > 0u) ? 1u : 0u; mine = (j == x) ? c : mine; }
        if (sum == G) break;
        __builtin_amdgcn_s_sleep(1);
        if ((++sp & 255u) == 0u) { if (xb_ld(&bar[XB_TMO])) break; if (sp > XB_SPIN_CAP) { atomicAdd(&bar[XB_TMO], 1u); break; } }
    }
    nloc = mine > 0u ? mine : 1u; nx = cnt > 0u ? cnt : 1u;
}
DI void xcd_barrier(const XcdBarrier& b) {
    asm volatile("s_waitcnt vmcnt(0)" ::: "memory");
    __syncthreads();
    if (threadIdx.x == 0) {
        unsigned* bar = b.bar;
        asm volatile("" : "+s"(bar));
        unsigned bx = b.x; asm volatile("" : "+s"(bx));
        __builtin_amdgcn_s_waitcnt(0);
        unsigned nloc = b.st[0], nx = b.st[1];
        if (nloc == 0u) { xcd_barrier_complete(bar, bx, nloc, nx); b.st[0] = nloc; b.st[1] = nx; }
        const unsigned old = xb_add(&bar[XB_XSUB(bx)], 1u);
        const unsigned gen = old / nloc;
        if (old + 1u == (gen + 1u) * nloc) {
            __builtin_amdgcn_fence(__ATOMIC_RELEASE, "agent");
            asm volatile("s_waitcnt vmcnt(0)" ::: "memory");
            const unsigned og = xb_add(&bar[XB_TOP], 1u);
            const unsigned tg = og / nx;
            if (og + 1u == (tg + 1u) * nx) xb_add(&bar[XB_TOPGEN], 1u);
            else XB_SPIN(xb_ld(&bar[XB_TOPGEN]) == tg, bar);
            __builtin_amdgcn_fence(__ATOMIC_ACQUIRE, "agent");
            xb_add(&bar[XB_XGEN(bx)], 1u);
            asm volatile("s_waitcnt vmcnt(0)" ::: "memory");
        } else {
            XB_SPIN(xb_ld(&bar[XB_XGEN(bx)]) == gen, bar);
            __builtin_amdgcn_fence(__ATOMIC_ACQUIRE, "agent");
            asm volatile("s_waitcnt vmcnt(0)" ::: "memory");
        }
    }
    __syncthreads();
}

struct TrTile { const float* src; bf16_t* dst; const float* gk; int N, K; };
DI TrTile tr_decode(KP P, unsigned char* ws, int u) {
    const int l = u / 2816, t = u % 2816;
    const float* W; bf16_t* Wt; const float* gv = nullptr; int K, N, tile; bool perm = false;
    if (t < 448) { W = P->in[3] + (size_t)l * 1024 * 1792; K = 1024; N = 1792; Wt = (bf16_t*)(ws + WS_WIN) + (size_t)l * 1792 * 1024; tile = t; gv = P->in[2] + l * 1024; }
    else if (t < 704) { W = P->in[20] + (size_t)l * 1024 * 1024; K = 1024; N = 1024; Wt = (bf16_t*)(ws + WS_WOUT) + (size_t)l * 1024 * 1024; tile = t - 448; }
    else if (t < 2112) { W = P->in[22] + (size_t)l * 1024 * 5632; K = 1024; N = 5632; Wt = (bf16_t*)(ws + WS_WF1) + (size_t)l * 5632 * 1024; tile = t - 704; perm = true; gv = P->in[21] + l * 1024; }
    else { W = P->in[25] + (size_t)l * 2816 * 1024; K = 2816; N = 1024; Wt = (bf16_t*)(ws + WS_WF2) + (size_t)l * 1024 * 2816; tile = t - 2112; }
    const int nk = K / 64, ntile = tile / nk, kt = tile % nk, n0 = ntile * 64, k0 = kt * 64;
    int sn0 = n0;
    if (perm) { const int pn = n0 >> 8, j = n0 & 255; sn0 = (j < 128) ? pn * 128 + j : DFF + pn * 128 + (j - 128); }
    TrTile r; r.src = W + (size_t)k0 * N + sn0; r.dst = Wt + (size_t)n0 * K + k0; r.gk = gv ? gv + k0 : nullptr; r.N = N; r.K = K; return r;
}
DI void transpose_group(KP P, unsigned char* ws, int grp, unsigned char* lds, int tid_) {
    const int tid = opaque_v(tid_);
    float* T = (float*)lds;
    f32x4 v[4][2];
#pragma unroll
    for (int j = 0; j < 4; ++j) {
        const TrTile t = tr_decode(P, ws, grp * 4 + j);
#pragma unroll
        for (int ps = 0; ps < 2; ++ps) { const int r = (tid >> 4) + 32 * ps, c4 = (tid & 15) * 4; v[j][ps] = *(const f32x4*)(t.src + (size_t)r * t.N + c4); if (t.gk) v[j][ps] = v[j][ps] * t.gk[r]; }
    }
#pragma unroll
    for (int j = 0; j < 4; ++j)
#pragma unroll
        for (int ps = 0; ps < 2; ++ps) { const int r = (tid >> 4) + 32 * ps, c4 = (tid & 15) * 4; float* Tj = T + j * 4160;
            Tj[(c4 + 0) * 65 + r] = v[j][ps][0]; Tj[(c4 + 1) * 65 + r] = v[j][ps][1]; Tj[(c4 + 2) * 65 + r] = v[j][ps][2]; Tj[(c4 + 3) * 65 + r] = v[j][ps][3]; }
    __syncthreads();
#pragma unroll
    for (int j = 0; j < 4; ++j) {
        const TrTile t = tr_decode(P, ws, grp * 4 + j);
        const int n = tid >> 3, kc = (tid & 7) * 8; const float* Tj = T + j * 4160;
        float f[8];
#pragma unroll
        for (int q = 0; q < 8; ++q) f[q] = Tj[n * 65 + kc + q];
        *(u32x4*)(t.dst + (size_t)n * t.K + kc) = pack8(f);
    }
    __syncthreads();
}

DI void xb_rows(const float* src0, const float* src1, bf16_t* XB, float* SS, int tid_, int bid, int G) {
    const int tid = opaque_v(tid_);
    const int w = tid >> 6, lane = tid & 63;
    for (int i = bid * 512 + tid; i < 3 * NT; i += G * 512) SS[NT + i] = 0.f;
    const int stride = G * 8;
    for (int row = bid * 8 + w; row < NT; row += 2 * stride) {
        const int row2 = row + stride; const bool has2 = row2 < NT;
        const float* sp = (row < NTP) ? src0 + (size_t)row * DM : src1 + (size_t)(row - NTP) * DM;
        const int r2 = has2 ? row2 : row;
        const float* sp2 = (r2 < NTP) ? src0 + (size_t)r2 * DM : src1 + (size_t)(r2 - NTP) * DM;
        f32x4 v[4], v2[4]; float ss = 0.f, ss2 = 0.f;
#pragma unroll
        for (int j = 0; j < 4; ++j) { v[j] = *(const f32x4*)(sp + j * 256 + lane * 4); v2[j] = *(const f32x4*)(sp2 + j * 256 + lane * 4); }
#pragma unroll
        for (int j = 0; j < 4; ++j) { ss += v[j][0] * v[j][0] + v[j][1] * v[j][1] + v[j][2] * v[j][2] + v[j][3] * v[j][3];
            ss2 += v2[j][0] * v2[j][0] + v2[j][1] * v2[j][1] + v2[j][2] * v2[j][2] + v2[j][3] * v2[j][3]; }
        ss = wave_sum(ss); ss2 = wave_sum(ss2);
#pragma unroll
        for (int j = 0; j < 4; ++j) {
            u32x2 o; o.x = pk2(v[j][0], v[j][1]); o.y = pk2(v[j][2], v[j][3]);
            *(u32x2*)(XB + (size_t)row * DM + j * 256 + lane * 4) = o;
        }
        if (lane == 0) SS[row] = ss;
        if (has2) {
#pragma unroll
            for (int j = 0; j < 4; ++j) {
                u32x2 o; o.x = pk2(v2[j][0], v2[j][1]); o.y = pk2(v2[j][2], v2[j][3]);
                *(u32x2*)(XB + (size_t)row2 * DM + j * 256 + lane * 4) = o;
            }
            if (lane == 0) SS[row2] = ss2;
        }
    }
}

DI void filter_tile(KP P, int l, int kind, int tile, unsigned char* lds, int tid_) {
    const int tid = opaque_v(tid_);
    const int L = kind ? 4096 : 16384, KRL = kind ? KRP_LEN : KRS_LEN;
    bf16_t* KR = (bf16_t*)(P->ws + (kind ? WS_KRP : WS_KRS)) + (size_t)l * 2 * 256 * KRL;
    const float* w1 = P->in[11] + l * 33 * 64; const float* b1 = P->in[12] + l * 64; const float* f1 = P->in[13] + l * 64;
    const float* w2 = P->in[14] + l * 64 * 64; const float* b2 = P->in[15] + l * 64; const float* f2 = P->in[16] + l * 64;
    const float* w3 = P->in[17] + (size_t)l * 64 * 1024; const float* hb = P->in[18] + l * 2 * 256;
    float* Z = (float*)lds;
    float* H1 = Z + 64 * 33;
    float* H2 = H1 + 64 * 64;
    bf16_t* OUT = (bf16_t*)(H2 + 64 * 64);
    const int t0 = tile * 64;
    for (int idx = tid; idx < 64 * 33; idx += 512) {
        const int t = idx / 33, e = idx % 33, n = t0 + t;
        float v;
        if (e == 0) v = (float)n / (float)(L - 1);
        else {
            const int bi = (e - 1) & 15;
            const float band = 1e-4f + (float)bi * ((15.0f - 1e-4f) / 15.0f);
            const float rev = (float)n * band / (float)L;
            v = (e <= 16) ? cos_rev(rev) : -sin_rev(rev);
        }
        Z[idx] = v;
    }
    __syncthreads();
    {
        const int j = tid & 63, tg = tid >> 6;
        float a[8];
#pragma unroll
        for (int i = 0; i < 8; ++i) a[i] = b1[j];
        for (int e = 0; e < 33; ++e) { const float w = w1[e * 64 + j];
#pragma unroll
            for (int i = 0; i < 8; ++i) a[i] += Z[(tg * 8 + i) * 33 + e] * w; }
        const float fr = f1[j];
#pragma unroll
        for (int i = 0; i < 8; ++i) H1[(tg * 8 + i) * 64 + j] = sin_rad(fr * a[i]);
    }
    __syncthreads();
    {
        const int j = tid & 63, tg = tid >> 6;
        float a[8];
#pragma unroll
        for (int i = 0; i < 8; ++i) a[i] = b2[j];
        for (int e = 0; e < 64; ++e) { const float w = w2[e * 64 + j];
#pragma unroll
            for (int i = 0; i < 8; ++i) a[i] += H1[(tg * 8 + i) * 64 + e] * w; }
        const float fr = f2[j];
#pragma unroll
        for (int i = 0; i < 8; ++i) H2[(tg * 8 + i) * 64 + j] = sin_rad(fr * a[i]);
    }
    __syncthreads();
    const int w = tid >> 6, lane = tid & 63, n = lane & 31, h = lane >> 5;
    bf16x8 afrag[2][4];
#pragma unroll
    for (int mb = 0; mb < 2; ++mb)
#pragma unroll
        for (int ks = 0; ks < 4; ++ks) {
            const float* hp = H2 + (mb * 32 + n) * 64 + ks * 16 + 8 * h;
            const f32x4 x0 = *(const f32x4*)hp, x1 = *(const f32x4*)(hp + 4);
            u32x4 pw; pw.x = pk2(x0[0], x0[1]); pw.y = pk2(x0[2], x0[3]); pw.z = pk2(x1[0], x1[1]); pw.w = pk2(x1[2], x1[3]);
            afrag[mb][ks] = __builtin_bit_cast(bf16x8, pw);
        }
    const int c = w * 32 + n;
    const float min_decay = -4.605170185988091f / 1.5f, max_decay = -4.605170185988091f / 0.3f;
    const float delta = fabsf(min_decay + (float)c * ((max_decay - min_decay) / 255.0f));
    for (int f = 0; f < 4; ++f) {
        f32x16 acc[2];
#pragma unroll
        for (int mb = 0; mb < 2; ++mb)
#pragma unroll
            for (int i = 0; i < 16; ++i) acc[mb][i] = 0.f;
#pragma unroll
        for (int ks = 0; ks < 4; ++ks) {
            const float* wp = w3 + (size_t)(ks * 16 + 8 * h) * 1024 + f * 256 + c;
            float wv[8];
#pragma unroll
            for (int j = 0; j < 8; ++j) wv[j] = wp[j * 1024];
            const bf16x8 bfrag = __builtin_bit_cast(bf16x8, pack8(wv));
#pragma unroll
            for (int mb = 0; mb < 2; ++mb) acc[mb] = __builtin_amdgcn_mfma_f32_32x32x16_bf16(afrag[mb][ks], bfrag, acc[mb], 0, 0, 0);
        }
#pragma unroll
        for (int mb = 0; mb < 2; ++mb)
#pragma unroll
            for (int i = 0; i < 16; ++i) {
                const int t = mb * 32 + crow(i, h);
                const float tn = (float)(t0 + t) / (float)(L - 1);
                float v = acc[mb][i] * __expf(-tn * delta);
                if ((f & 1) == 0 && (t0 + t) == 0) v += hb[(f >> 1) * 256 + c];
                OUT[c * 72 + t] = f2bf(v);
            }
        __syncthreads();
        const int o = f >> 1;
        for (int item = tid; item < 256 * 64; item += 512) {
            const int cc = item >> 6, t = item & 63, nn = t0 + t;
            bf16_t* arr = KR + (size_t)(o * 256 + cc) * KRL;
            const bf16_t v = OUT[cc * 72 + t];
            if ((f & 1) == 0) arr[KR_PAD + L - nn] = v;
            else if (nn > 0) arr[KR_PAD + L + nn] = v;
        }
        __syncthreads();
    }
}

DI void attn_unit(KP P, int l, int unit, unsigned char* lds, int tid_) {
    const int tid = opaque_v(tid_);
    const unsigned z0_ = (unsigned)opaque_v(0); const u32x4 zero4 = {z0_, z0_, z0_, z0_};
    const bf16_t* Pm = (const bf16_t*)(P->ws + WS_P);
    bf16_t* HB = (bf16_t*)(P->out);
    const int qb = unit >> 1, g = unit & 1;
    const int tokq0 = qb * 128; int s0, L; seq_info(tokq0, s0, L);
    const int pos0 = tokq0 - s0;
    bf16_t* Kl = (bf16_t*)lds;
    bf16_t* Vt = (bf16_t*)(lds + 55296);
    const float* kng = P->in[5] + l * 64; const float* qng = P->in[4] + l * 64;
#pragma unroll
    for (int j_ = 0; j_ < 6; ++j_) {
        const int item = tid + 512 * j_;
        const int i = item >> 3, ch = item & 7, kpos = pos0 - 128 + i;
        u32x4 raw = zero4;
        if (kpos >= 0 && kpos < L) raw = *(const u32x4*)(Pm + (size_t)(s0 + kpos) * NIN + 512 + g * 64 + ch * 8);
        float f[8]; unpack8(raw, f);
        float ss = 0.f;
#pragma unroll
        for (int j = 0; j < 8; ++j) ss += f[j] * f[j];
        ss += __shfl_xor(ss, 1); ss += __shfl_xor(ss, 2); ss += __shfl_xor(ss, 4);
        const float rs = rsqrtf(ss * (1.0f / 64.0f) + EPSV);
#pragma unroll
        for (int j = 0; j < 8; ++j) f[j] *= rs * kng[ch * 8 + j];
        *(u32x4*)(Kl + i * 72 + ch * 8) = pack8(f);
    }
#pragma unroll
    for (int j_ = 0; j_ < 6; ++j_) {
        const int item = tid + 512 * j_;
        const int ch = item / 384, i = item % 384, kpos = pos0 - 128 + i;
        u32x4 raw = zero4;
        if (kpos >= 0 && kpos < L) raw = *(const u32x4*)(Pm + (size_t)(s0 + kpos) * NIN + 640 + g * 64 + ch * 8);
        bf16_t* vp = Vt + (ch * 8) * 392 + i;
        vp[0] = (bf16_t)(raw.x & 0xffff); vp[392] = (bf16_t)(raw.x >> 16); vp[2 * 392] = (bf16_t)(raw.y & 0xffff); vp[3 * 392] = (bf16_t)(raw.y >> 16);
        vp[4 * 392] = (bf16_t)(raw.z & 0xffff); vp[5 * 392] = (bf16_t)(raw.z >> 16); vp[6 * 392] = (bf16_t)(raw.w & 0xffff); vp[7 * 392] = (bf16_t)(raw.w >> 16);
    }
    __syncthreads();
    const int w = __builtin_amdgcn_readfirstlane(tid >> 6), lane = tid & 63, r = lane & 31, h = lane >> 5;
    const int hq = g * 4 + (w >> 1), qoff = (w & 1) * 64;
    const float slope2 = exp2f(-(float)(hq + 1)) * LOG2E;
    const float sink2 = P->in[6][l * 8 + hq] * LOG2E;
    const float qscale = 0.125f * LOG2E;
    bf16x8 qf[2][4];
#pragma unroll
    for (int qg = 0; qg < 2; ++qg) {
        const int tok = tokq0 + qoff + qg * 32 + r;
        u32x4 raw[4]; float ss = 0.f;
#pragma unroll
        for (int c = 0; c < 4; ++c) { raw[c] = *(const u32x4*)(Pm + (size_t)tok * NIN + hq * 64 + 16 * c + 8 * h);
            float f[8]; unpack8(raw[c], f);
#pragma unroll
            for (int j = 0; j < 8; ++j) ss += f[j] * f[j]; }
        ss += __shfl_xor(ss, 32);
        const float rs = rsqrtf(ss * (1.0f / 64.0f) + EPSV) * qscale;
#pragma unroll
        for (int c = 0; c < 4; ++c) { float f[8]; unpack8(raw[c], f);
#pragma unroll
            for (int j = 0; j < 8; ++j) f[j] *= rs * qng[16 * c + 8 * h + j];
            qf[qg][c] = __builtin_bit_cast(bf16x8, pack8(f)); }
    }
    f32x16 o[2][2]; float rsum[2] = {0.f, 0.f};
#pragma unroll
    for (int a = 0; a < 2; ++a)
#pragma unroll
        for (int b = 0; b < 2; ++b)
#pragma unroll
            for (int i = 0; i < 16; ++i) o[a][b][i] = 0.f;
    const int kb_lo = qoff >> 5;
    for (int kb = kb_lo; kb < kb_lo + 10; ++kb) {
        const int i0 = kb * 32;
        bf16x8 kf[4];
#pragma unroll
        for (int c = 0; c < 4; ++c) kf[c] = *(const bf16x8*)(Kl + (i0 + r) * 72 + 16 * c + 8 * h);
        bf16x8 pf[2][2];
#pragma unroll
        for (int qg = 0; qg < 2; ++qg) {
            f32x16 s;
#pragma unroll
            for (int i = 0; i < 16; ++i) s[i] = 0.f;
#pragma unroll
            for (int c = 0; c < 4; ++c) s = __builtin_amdgcn_mfma_f32_32x32x16_bf16(kf[c], qf[qg][c], s, 0, 0, 0);
            const int qrel = qoff + qg * 32 + r + 128;
            float pv[16];
            const int rel = i0 - (qoff + qg * 32 + 128);
            const bool inseq = (pos0 - 128 + i0 >= 0) && (pos0 - 128 + i0 + 31 < L);
            if (rel < -128 || rel > 128) {
#pragma unroll
                for (int i = 0; i < 16; ++i) pv[i] = 0.f;
            } else if (inseq && rel != 0 && rel >= -96 && rel <= 96) {
                const float ssl = rel < 0 ? slope2 : -slope2;
                const float base = ssl * (float)(i0 + 4 * h - qrel);
#pragma unroll
                for (int i = 0; i < 16; ++i) {
                    const float e = __builtin_amdgcn_exp2f(s[i] + (base + ssl * (float)crow(i, 0)));
                    pv[i] = e; rsum[qg] += e;
                }
            } else {
#pragma unroll
                for (int i = 0; i < 16; ++i) {
                    const int ki = i0 + crow(i, h);
                    int dist = qrel - ki; dist = dist < 0 ? -dist : dist;
                    const int kpos = pos0 - 128 + ki;
                    const bool valid = (dist <= 128) && (kpos >= 0) && (kpos < L);
                    const float e = __builtin_amdgcn_exp2f(s[i] - slope2 * (float)dist);
                    pv[i] = valid ? e : 0.f;
                    rsum[qg] += pv[i];
                }
            }
#pragma unroll
            for (int sx = 0; sx < 2; ++sx) {
                u32x4 pw; pw.x = pk2(pv[8 * sx], pv[8 * sx + 1]); pw.y = pk2(pv[8 * sx + 2], pv[8 * sx + 3]); pw.z = pk2(pv[8 * sx + 4], pv[8 * sx + 5]); pw.w = pk2(pv[8 * sx + 6], pv[8 * sx + 7]);
                pf[qg][sx] = __builtin_bit_cast(bf16x8, pw);
            }
        }
#pragma unroll
        for (int dt = 0; dt < 2; ++dt)
#pragma unroll
            for (int sx = 0; sx < 2; ++sx) {
                const bf16_t* vb = Vt + (dt * 32 + r) * 392 + i0 + 16 * sx + 4 * h;
                const u32x2 lo = *(const u32x2*)vb, hi = *(const u32x2*)(vb + 8);
                u32x4 vv; vv.x = lo.x; vv.y = lo.y; vv.z = hi.x; vv.w = hi.y;
                const bf16x8 vf = __builtin_bit_cast(bf16x8, vv);
#pragma unroll
                for (int qg = 0; qg < 2; ++qg) o[qg][dt] = __builtin_amdgcn_mfma_f32_32x32x16_bf16(vf, pf[qg][sx], o[qg][dt], 0, 0, 0);
            }
    }
#pragma unroll
    for (int qg = 0; qg < 2; ++qg) {
        float lsum = rsum[qg] + __shfl_xor(rsum[qg], 32) + __builtin_amdgcn_exp2f(sink2);
        const float inv = 1.0f / lsum;
        const int tok = tokq0 + qoff + qg * 32 + r;
#pragma unroll
        for (int dt = 0; dt < 2; ++dt)
#pragma unroll
            for (int gq = 0; gq < 4; ++gq) {
                u32x2 ov; ov.x = pk2(o[qg][dt][4 * gq] * inv, o[qg][dt][4 * gq + 1] * inv); ov.y = pk2(o[qg][dt][4 * gq + 2] * inv, o[qg][dt][4 * gq + 3] * inv);
                *(u32x2*)(HB + (size_t)tok * DM + hq * 64 + dt * 32 + 8 * gq + 4 * h) = ov;
            }
    }
    __syncthreads();
}

DI void pool_unit(KP P, int l, int unit, unsigned char* lds, int tid_) {
    const int tid = opaque_v(tid_);
    const unsigned z0_ = (unsigned)opaque_v(0); const u32x4 zero4 = {z0_, z0_, z0_, z0_};
    const bf16_t* Pm = (const bf16_t*)(P->ws + WS_P);
    bf16_t* HB = (bf16_t*)(P->out);
    const int tok0 = unit * 64; int s0, L; seq_info(tok0, s0, L);
    const int pos0 = tok0 - s0;
    bf16_t* U = (bf16_t*)lds;
    bf16_t* DT = (bf16_t*)(lds + 40960);
#pragma unroll
    for (int j_ = 0; j_ < 5; ++j_) {
        const int item = tid + 512 * j_;
        const int rr = item >> 5, ch = item & 31, pos = pos0 - 8 + rr;
        u32x4 raw = zero4;
        if (pos >= 0 && pos < L) raw = *(const u32x4*)(Pm + (size_t)(s0 + pos) * NIN + 768 + ch * 8);
        *(u32x4*)(U + rr * 256 + ch * 8) = raw;
    }
    __syncthreads();
    const int c = tid & 255, th = tid >> 8, gi = c >> 6, hw = 1 << gi;
    {
        const int tfirst = th * 32;
        float sum = 0.f;
        for (int s = tfirst - hw; s < tfirst + hw; ++s) sum += bf2f(U[(s + 8) * 256 + c]);
        for (int tt = 0; tt < 32; ++tt) {
            const int t = tfirst + tt, pos = pos0 + t;
            const int lo = max(pos - hw, 0), hi = min(pos + hw, L);
            const float d = sum / (float)(hi - lo) - bf2f(U[(t + 8) * 256 + c]);
            DT[t * 264 + c] = f2bf(d);
            sum += bf2f(U[(t + hw + 8) * 256 + c]) - bf2f(U[(t - hw + 8) * 256 + c]);
        }
    }
    __syncthreads();
    {
        const int w = __builtin_amdgcn_readfirstlane(tid >> 6), lane = tid & 63, n = lane & 31, h = lane >> 5;
        const int g = w >> 1, nb = w & 1;
        const float* W = P->in[7] + (size_t)l * 4 * 64 * 64 + g * 4096 + 32 * nb + n;
        bf16x8 bw[4];
#pragma unroll
        for (int ks = 0; ks < 4; ++ks) {
            float wv[8];
#pragma unroll
            for (int j = 0; j < 8; ++j) wv[j] = W[(16 * ks + 8 * h + j) * 64];
            bw[ks] = __builtin_bit_cast(bf16x8, pack8(wv));
        }
        f32x16 acc[2];
#pragma unroll
        for (int mb = 0; mb < 2; ++mb) {
#pragma unroll
            for (int i = 0; i < 16; ++i) acc[mb][i] = 0.f;
#pragma unroll
            for (int ks = 0; ks < 4; ++ks) {
                const bf16x8 af = *(const bf16x8*)(DT + (32 * mb + n) * 264 + g * 64 + 16 * ks + 8 * h);
                acc[mb] = __builtin_amdgcn_mfma_f32_32x32x16_bf16(af, bw[ks], acc[mb], 0, 0, 0);
            }
        }
        const int oc = g * 64 + 32 * nb + n;
        const float sc = P->in[8][l * 256 + oc];
#pragma unroll
        for (int mb = 0; mb < 2; ++mb)
#pragma unroll
            for (int i = 0; i < 16; ++i) HB[(size_t)(tok0 + 32 * mb + crow(i, h)) * DM + 512 + oc] = f2bf(acc[mb][i] * sc);
    }
    __syncthreads();
}

DI void prep_unit(KP P, int l, int unit, unsigned char* lds, int tid_) {
    const int tid = opaque_v(tid_);
    const unsigned z0_ = (unsigned)opaque_v(0); const u32x4 zero4 = {z0_, z0_, z0_, z0_};
    const bf16_t* Pm = (const bf16_t*)(P->ws + WS_P);
    bf16_t* HY = (bf16_t*)(P->ws + WS_HY);
    const int tok0 = unit * 64; int s0, L; seq_info(tok0, s0, L);
    const int pos0 = tok0 - s0;
    unsigned* Tw = (unsigned*)lds;
    const float* cw = P->in[9] + (size_t)l * 3 * 768; const float* cb = P->in[10] + l * 768;
    if (tid < 480) {
        const int ch = tid % 96, tg = tid / 96, col = ch * 8, tfirst = 13 * tg;
        const f32x4 w0a = *(const f32x4*)(cw + col), w0b = *(const f32x4*)(cw + col + 4), w1a = *(const f32x4*)(cw + 768 + col), w1b = *(const f32x4*)(cw + 768 + col + 4);
        const f32x4 w2a = *(const f32x4*)(cw + 1536 + col), w2b = *(const f32x4*)(cw + 1536 + col + 4), bba = *(const f32x4*)(cb + col), bbb = *(const f32x4*)(cb + col + 4);
        u32x4 rows[15];
#pragma unroll
        for (int r = 0; r < 15; ++r) {
            const int t = tfirst - 1 + r, pos = pos0 + t;
            rows[r] = zero4;
            if (t <= 64 && pos >= 0 && pos < L) rows[r] = *(const u32x4*)(Pm + (size_t)(s0 + pos) * NIN + 1024 + col);
        }
#pragma unroll
        for (int i = 0; i < 13; ++i) {
            const int t = tfirst + i;
            if (t < 64) {
                float fa[8], fb[8], fd[8]; unpack8(rows[i], fa); unpack8(rows[i + 1], fb); unpack8(rows[i + 2], fd);
                bf16_t* Tb = (bf16_t*)(Tw + (((t >> 1) + ch) & 31)) + (t & 1);
#pragma unroll
                for (int j = 0; j < 8; ++j) {
                    const float w0 = j < 4 ? w0a[j & 3] : w0b[j & 3], w1 = j < 4 ? w1a[j & 3] : w1b[j & 3], w2 = j < 4 ? w2a[j & 3] : w2b[j & 3], bb = j < 4 ? bba[j & 3] : bbb[j & 3];
                    const float v = fa[j] * w0 + fb[j] * w1 + fd[j] * w2 + bb;
                    Tb[(col + j) * 66] = f2bf(v);
                }
            }
        }
    }
    __syncthreads();
#pragma unroll 4
    for (int j_ = 0; j_ < 12; ++j_) {
        const int item = tid + 512 * j_;
        const int cc = item >> 3, q = item & 7, rot = cc >> 3;
        const unsigned* rowp = Tw + cc * 33;
        u32x4 v; v.x = rowp[(4 * q + rot) & 31]; v.y = rowp[(4 * q + 1 + rot) & 31]; v.z = rowp[(4 * q + 2 + rot) & 31]; v.w = rowp[(4 * q + 3 + rot) & 31];
        const int arr = cc >> 8, ch = cc & 255;
        *(u32x4*)(HY + (size_t)arr * HY_ARR + (size_t)ch * NT + tok0 + q * 8) = v;
    }
    __syncthreads();
}

template <bool SAMPLE>
DI void hyena_unit(const bf16_t* Uin, const bf16_t* Gate, bf16_t* Zout, const bf16_t* kr, int c, unsigned char* lds, int tid_) {
    const int tid = opaque_v(tid_);
    constexpr int NB = SAMPLE ? 128 : 32;
    constexpr int L = NB * 128;
    constexpr int KRL = 2 * L + 512;
    constexpr int SEQ_STRIDE = 8768;
    constexpr int ZERO_OFF = SAMPLE ? 128 * 272 : 8 * SEQ_STRIDE;
    constexpr int KR_OFF = SAMPLE ? 35328 : 70656;
    const int w = __builtin_amdgcn_readfirstlane(tid >> 6), lane = tid & 63, n = lane & 31, h = lane >> 5;
    {
        constexpr int NU = SAMPLE ? 4 : 8;
        constexpr int NK = (KRL / 8 + 511) / 512;
        u32x4 uv[NU], kv[NK];
#pragma unroll
        for (int j = 0; j < NU; ++j) uv[j] = *(const u32x4*)(Uin + (size_t)c * NT + (SAMPLE ? NTP : 0) + (tid + 512 * j) * 8);
#pragma unroll
        for (int j = 0; j < NK; ++j) { const int item = tid + 512 * j; kv[j] = *(const u32x4*)(kr + (item < KRL / 8 ? item : 0) * 8); }
#pragma unroll
        for (int j = 0; j < NU; ++j) {
            const int t8 = (tid + 512 * j) * 8;
            if (SAMPLE) { const int a = t8 >> 7, wi = t8 & 127; *(u32x4*)(lds + a * 272 + wi * 2) = uv[j]; }
            else { const int b = t8 >> 12, tt = t8 & 4095, a = tt >> 7, wi = tt & 127; *(u32x4*)(lds + b * SEQ_STRIDE + a * 272 + wi * 2) = uv[j]; }
        }
#pragma unroll
        for (int j = 0; j < NK; ++j) { const int item = tid + 512 * j; if (item < KRL / 8) *(u32x4*)(lds + KR_OFF + item * 16) = kv[j]; }
    }
    if (tid < 17) { const unsigned z0_ = (unsigned)opaque_v(0); *(u32x4*)(lds + ZERO_OFF + tid * 16) = (u32x4){z0_, z0_, z0_, z0_}; }
    __syncthreads();
    if (!SAMPLE) {
        constexpr int NCH = KRL / 8;
        for (int task = tid; task < 3 * NCH; task += 512) {
            const int e = task / NCH + 1, ch = task % NCH;
            const unsigned* src = (const unsigned*)(lds + KR_OFF) + ch * 4;
            const u32x4 d03 = *(const u32x4*)src; const unsigned d4 = src[4], d5 = src[5];
            const bool k1 = (e >> 1) != 0; const unsigned shb = (unsigned)(e & 1) * 16u;
            const unsigned e0 = k1 ? d03.y : d03.x, e1 = k1 ? d03.z : d03.y, e2 = k1 ? d03.w : d03.z, e3 = k1 ? d4 : d03.w, e4 = k1 ? d5 : d4;
            u32x4 o; o.x = __builtin_amdgcn_alignbit(e1, e0, shb); o.y = __builtin_amdgcn_alignbit(e2, e1, shb); o.z = __builtin_amdgcn_alignbit(e3, e2, shb); o.w = __builtin_amdgcn_alignbit(e4, e3, shb);
            *(u32x4*)(lds + KR_OFF + e * (KRL * 2) + ch * 16) = o;
        }
        __syncthreads();
    }
    const int a_n = SAMPLE ? 32 * (w & 3) + n : 4 * w + (n & 3);
    const int b_n = SAMPLE ? 0 : (n >> 2);
    const unsigned char* ubase = lds + b_n * SEQ_STRIDE;
    const int dlo = SAMPLE ? 32 * (w & 3) - 127 : 4 * w - 31;
    const int dhi = SAMPLE ? 32 * (w & 3) + 31 : 4 * w + 3;
    const int idxc = 8 * h - n + L + KR_PAD;
    const int esh = (4 - (n & 3)) & 3;
    const bool ek = (esh >> 1) != 0;
    const unsigned sh = (unsigned)(esh & 1) * 16u;
    const unsigned char* lb = lds + KR_OFF + (SAMPLE ? 0 : esh * (KRL * 2)) + (idxc - esh) * 2 - 6 * 32;
    f32x16 acc[4];
#pragma unroll
    for (int r = 0; r < 4; ++r)
#pragma unroll
        for (int i = 0; i < 16; ++i) acc[r][i] = 0.f;
    const int dfirst = SAMPLE ? ((w >> 2) ? dlo + 80 : dlo) : dlo;
    const int dlast = SAMPLE ? ((w >> 2) ? dhi : dlo + 79) : dhi;
    bf16x8 afr[24];
#define HY_FRAG(dst, ab, d) do { const u32x2* p_ = (const u32x2*)((ab) + (d) * 32); \
        if (SAMPLE) { const u32x2 x0 = p_[0], x1 = p_[1], x2 = p_[2]; \
            const unsigned e0 = ek ? x0.y : x0.x, e1 = ek ? x1.x : x0.y, e2 = ek ? x1.y : x1.x, e3 = ek ? x2.x : x1.y, e4 = ek ? x2.y : x2.x; \
            u32x4 o_; o_.x = __builtin_amdgcn_alignbit(e1, e0, sh); o_.y = __builtin_amdgcn_alignbit(e2, e1, sh); o_.z = __builtin_amdgcn_alignbit(e3, e2, sh); o_.w = __builtin_amdgcn_alignbit(e4, e3, sh); \
            dst = __builtin_bit_cast(bf16x8, o_); } \
        else { const u32x2 x0 = p_[0], x1 = p_[1]; u32x4 o_; o_.x = x0.x; o_.y = x0.y; o_.z = x1.x; o_.w = x1.y; dst = __builtin_bit_cast(bf16x8, o_); } } while (0)
#define HY_MMA(SO) do { const int blk = a_n - delta; const bool valid = (blk >= 0) && (blk < NB); \
        const unsigned char* bp = valid ? ubase + blk * 272 + 16 * h : lds + ZERO_OFF + 16 * h; const int qs = valid ? 32 : 0; \
        bf16x8 bfr[8]; \
        _Pragma("unroll") for (int q = 0; q < 8; ++q) bfr[q] = *(const bf16x8*)(bp + qs * q); \
        __builtin_amdgcn_s_setprio(1); \
        _Pragma("unroll") for (int q = 0; q < 8; ++q) _Pragma("unroll") for (int r = 0; r < 4; ++r) \
            acc[r] = __builtin_amdgcn_mfma_f32_32x32x16_bf16(afr[(q - 2 * r + 6 + (SO)) % 24], bfr[q], acc[r], 0, 0, 0); \
        __builtin_amdgcn_s_setprio(0); } while (0)
#define HY_NEXT(NBASE) do { const unsigned char* ab_ = lb - (delta + 1) * 256; \
        _Pragma("unroll") for (int d = 0; d < 8; ++d) HY_FRAG(afr[(NBASE) + d], ab_, d); } while (0)
    {
        const unsigned char* ab = lb - dfirst * 256;
#pragma unroll
        for (int d = 0; d < 14; ++d) HY_FRAG(afr[d], ab, d);
    }
    for (int delta = dfirst;;) {
        HY_MMA(0); HY_NEXT(16);
        if (++delta > dlast) break;
        HY_MMA(16); HY_NEXT(8);
        if (++delta > dlast) break;
        HY_MMA(8); HY_NEXT(0);
        if (++delta > dlast) break;
    }
#undef HY_NEXT
#undef HY_MMA
#undef HY_FRAG
    if (SAMPLE) {
        __syncthreads();
        float* RED = (float*)(lds + KR_OFF);
        if (w >= 4) {
#pragma unroll
            for (int r = 0; r < 4; ++r)
#pragma unroll
                for (int i = 0; i < 16; ++i) RED[((w & 3) * 64 + r * 16 + i) * 64 + lane] = acc[r][i];
        }
        __syncthreads();
        if (w < 4) {
#pragma unroll
            for (int r = 0; r < 4; ++r)
#pragma unroll
                for (int i = 0; i < 16; ++i) acc[r][i] += RED[(w * 64 + r * 16 + i) * 64 + lane];
        }
    }
    if (!SAMPLE || w < 4) {
        const size_t tb = (size_t)c * NT + (SAMPLE ? NTP + a_n * 128 : b_n * 4096 + a_n * 128);
#pragma unroll
        for (int r = 0; r < 4; ++r)
#pragma unroll
            for (int gq = 0; gq < 4; ++gq) {
                const size_t idx = tb + 32 * r + 8 * gq + 4 * h;
                const u32x2 gv = *(const u32x2*)(Gate + idx);
                u32x2 ov; ov.x = pk2(acc[r][4 * gq] * bflo(gv.x), acc[r][4 * gq + 1] * bfhi(gv.x)); ov.y = pk2(acc[r][4 * gq + 2] * bflo(gv.y), acc[r][4 * gq + 3] * bfhi(gv.y));
                *(u32x2*)(Zout + idx) = ov;
            }
    }
    __syncthreads();
}

DI void fin_unit(KP P, int l, int unit, unsigned char* lds, int tid_) {
    const int tid = opaque_v(tid_);
    bf16_t* HB = (bf16_t*)(P->out);
    const bf16_t* Z2 = (const bf16_t*)(P->ws + WS_HY);
    const float* og = P->in[19] + l * 1024;
    const int tok0 = unit * 64;
    float* T = (float*)lds;
    const int w = tid >> 6, lane = tid & 63;
    u32x4 ra[8]; u32x2 rb[8];
#pragma unroll
    for (int rr = 0; rr < 8; ++rr) { const bf16_t* row = HB + (size_t)(tok0 + w * 8 + rr) * DM; ra[rr] = *(const u32x4*)(row + lane * 8); rb[rr] = *(const u32x2*)(row + 512 + lane * 4); }
    const f32x4 ga0 = *(const f32x4*)(og + lane * 8), ga1 = *(const f32x4*)(og + lane * 8 + 4), gb = *(const f32x4*)(og + 512 + lane * 4), gc = *(const f32x4*)(og + 768 + lane * 4);
    u32x4 zv[4];
#pragma unroll
    for (int j_ = 0; j_ < 4; ++j_) { const int item = tid + 512 * j_; zv[j_] = *(const u32x4*)(Z2 + (size_t)(item >> 3) * NT + tok0 + (item & 7) * 8); }
#pragma unroll
    for (int j_ = 0; j_ < 4; ++j_) {
        const int item = tid + 512 * j_;
        const int cc = item >> 3, q = item & 7;
        float f[8]; unpack8(zv[j_], f);
#pragma unroll
        for (int j = 0; j < 8; ++j) T[(q * 8 + j) * 257 + cc] = f[j];
    }
    __syncthreads();
#pragma unroll
    for (int rr = 0; rr < 8; ++rr) {
        const int t = w * 8 + rr; bf16_t* row = HB + (size_t)(tok0 + t) * DM;
        {
            float f[8]; unpack8(ra[rr], f); float ss = 0.f;
#pragma unroll
            for (int j = 0; j < 8; ++j) ss += f[j] * f[j];
            ss = wave_sum(ss); const float rs = __builtin_amdgcn_rsqf(ss * (1.0f / 512.0f) + EPSV);
#pragma unroll
            for (int j = 0; j < 4; ++j) { f[j] *= rs * ga0[j]; f[4 + j] *= rs * ga1[j]; }
            *(u32x4*)(row + lane * 8) = pack8(f);
        }
        {
            const u32x2 raw = rb[rr];
            float f0 = bflo(raw.x), f1 = bfhi(raw.x), f2 = bflo(raw.y), f3 = bfhi(raw.y);
            float ss = wave_sum(f0 * f0 + f1 * f1 + f2 * f2 + f3 * f3); const float rs = __builtin_amdgcn_rsqf(ss * (1.0f / 256.0f) + EPSV);
            u32x2 ov; ov.x = pk2(f0 * rs * gb[0], f1 * rs * gb[1]); ov.y = pk2(f2 * rs * gb[2], f3 * rs * gb[3]);
            *(u32x2*)(row + 512 + lane * 4) = ov;
        }
        {
            const float* tp = T + t * 257 + lane * 4;
            const float f0 = tp[0], f1 = tp[1], f2 = tp[2], f3 = tp[3];
            float ss = wave_sum(f0 * f0 + f1 * f1 + f2 * f2 + f3 * f3); const float rs = __builtin_amdgcn_rsqf(ss * (1.0f / 256.0f) + EPSV);
            u32x2 ov; ov.x = pk2(f0 * rs * gc[0], f1 * rs * gc[1]); ov.y = pk2(f2 * rs * gc[2], f3 * rs * gc[3]);
            *(u32x2*)(row + 768 + lane * 4) = ov;
        }
    }
    __syncthreads();
}

__global__ void __launch_bounds__(512, 2) mega(Params Parg) {
    extern __shared__ __attribute__((aligned(16))) unsigned char lds[];
    cg::grid_group grid = cg::this_grid();
    LAS unsigned char* ldsl = (LAS unsigned char*)lds;
    const int tid = threadIdx.x;
    KP Pk = (KP)__builtin_amdgcn_kernarg_segment_ptr();
#define PH_BEGIN() KP P = Pk; asm volatile("" : "+s"(P)); const int bid = opaque_s(blockIdx.x), G = opaque_s(gridDim.x); unsigned char* ws = P->ws; (void)ws; (void)bid; (void)G
    volatile LAS unsigned* stw = (volatile LAS unsigned*)(ldsl + LDS_BYTES - 16);
    if (tid < 4) stw[tid] = 0u;
    __syncthreads();
    const XcdBarrier xb = xcd_barrier_post((unsigned*)(Pk->ws + WS_BAR), stw);
#define GSYNC() xcd_barrier(xb)

    if constexpr ((PHM & 1) != 0) for (int rep = 0; rep < REP_P0; ++rep) {
        PH_BEGIN();
        for (int u = bid; u < 2 * 2816 / 4; u += G) transpose_group(P, ws, u, lds, tid);
        for (int u = bid; u < 2 * 320; u += G) {
            const int l = u / 320, t = u % 320;
            if (t < 256) filter_tile(P, l, 0, t, lds, tid); else filter_tile(P, l, 1, t - 256, lds, tid);
        }
        for (int idx = bid * 512 + tid; idx < 2048 * 513; idx += G * 512) {
            const int arr = idx / 513, j = idx % 513;
            const int kind = arr >> 10, a = arr & 1023;
            const int Lx = kind ? 4096 : 16384, KRL = kind ? KRP_LEN : KRS_LEN;
            bf16_t* base = (bf16_t*)(ws + (kind ? WS_KRP : WS_KRS)) + (size_t)a * KRL;
            base[j <= 256 ? j : 2 * Lx + j - 1] = 0;
        }
        xb_rows(P->in[0], P->in[1], (bf16_t*)(ws + WS_HB), (float*)(ws + WS_SS), tid, bid, G);
    }
    if (Pk->ws == nullptr) grid.sync();
    GSYNC();

    for (int l = 0; l < 2; ++l) {
        if constexpr ((PHM & 2) != 0) {
            PH_BEGIN();
            pg8::Gemm g{(const bf16_t*)(ws + WS_HB), (const bf16_t*)(ws + WS_WIN) + (size_t)l * 1792 * 1024, 1024};
            pg8::StaticOrder S; S.init(NT, NIN, G, bid);
            pg8::EpiBf16 E{(bf16_t*)(ws + WS_P), NIN, (const float*)(ws + WS_SS) + (size_t)(l == 0 ? 0 : 2) * NT};
            for (int rep = 0; rep < REP_L1; ++rep) pg8::gemm_phase<pg8::EpiBf16, pg8::StaticOrder, true, 1024>(ldsl, g, S, E);
        }
        GSYNC();
        {
            PH_BEGIN();
            for (int rep = 0; rep < REP_L2; ++rep)
            for (int u = bid; u < 3 * 768; u += G) {
                if (u < 768) { if constexpr ((PHM & 4) != 0) attn_unit(P, l, u, lds, tid); }
                else if (u < 1536) { if constexpr ((PHM & 8) != 0) pool_unit(P, l, u - 768, lds, tid); }
                else { if constexpr ((PHM & 16) != 0) prep_unit(P, l, u - 1536, lds, tid); }
            }
        }
        GSYNC();
        for (int o = 0; o < 2; ++o) {
            {
                PH_BEGIN();
                bf16_t* HY = (bf16_t*)(ws + WS_HY);
                const bf16_t* Uin = o == 0 ? HY : HY + 3 * HY_ARR;
                const bf16_t* Gt = HY + (size_t)(1 + o) * HY_ARR;
                bf16_t* Zo = o == 0 ? HY + 3 * HY_ARR : HY;
                for (int rep = 0; rep < REP_HY; ++rep)
                for (int u = bid; u < 512; u += G) {
                    const int c = u & 255;
                    if constexpr ((PHM & 32) != 0) { if (u < 256) hyena_unit<true>(Uin, Gt, Zo, (const bf16_t*)(ws + WS_KRS) + (size_t)((l * 2 + o) * 256 + c) * KRS_LEN, c, lds, tid);
                    else hyena_unit<false>(Uin, Gt, Zo, (const bf16_t*)(ws + WS_KRP) + (size_t)((l * 2 + o) * 256 + c) * KRP_LEN, c, lds, tid); }
                }
            }
            GSYNC();
        }
        if constexpr ((PHM & 64) != 0) { PH_BEGIN(); for (int u = bid; u < 768; u += G) fin_unit(P, l, u, lds, tid); }
        GSYNC();
        if constexpr ((PHM & 128) != 0) {
            PH_BEGIN();
            pg8::Gemm g{(const bf16_t*)(P->out), (const bf16_t*)(ws + WS_WOUT) + (size_t)l * 1024 * 1024, 1024};
            pg8::StaticOrder S; S.init(NT, DM, G, bid);
            pg8::EpiResid<false> E{(bf16_t*)(ws + WS_HB), (float*)(ws + WS_SS) + (size_t)(l == 0 ? 1 : 3) * NT, nullptr};
            pg8::gemm_phase<pg8::EpiResid<false>, pg8::StaticOrder, true, 1024>(ldsl, g, S, E);
        }
        GSYNC();
        if constexpr ((PHM & 256) != 0) {
            PH_BEGIN();
            pg8::Gemm g{(const bf16_t*)(ws + WS_HB), (const bf16_t*)(ws + WS_WF1) + (size_t)l * 5632 * 1024, 1024};
            pg8::FfnOrder S; S.G = G; S.vb = (G % 8 == 0) ? (bid % 8) * (G / 8) + bid / 8 : bid;
            pg8::EpiFfnReg E{(bf16_t*)(ws + WS_ACT), P->in[23] + (size_t)l * 3 * NFF2, P->in[24] + (size_t)l * NFF2, (const float*)(ws + WS_SS) + (size_t)(l == 0 ? 1 : 3) * NT};
            for (int rep = 0; rep < REP_FFN; ++rep) pg8::gemm_phase<pg8::EpiFfnReg, pg8::FfnOrder, true, 1024, 62>(ldsl, g, S, E);
        }
        GSYNC();
        if constexpr ((PHM & 512) != 0) {
            PH_BEGIN();
            pg8::Gemm g{(const bf16_t*)(ws + WS_ACT), (const bf16_t*)(ws + WS_WF2) + (size_t)l * 1024 * 2816, 2816};
            pg8::StaticOrder S; S.init(NT, DM, G, bid);
            if (l == 0) {
                pg8::EpiResid<false> E{(bf16_t*)(ws + WS_HB), (float*)(ws + WS_SS) + (size_t)2 * NT, nullptr};
                pg8::gemm_phase<pg8::EpiResid<false>, pg8::StaticOrder, true, 2816>(ldsl, g, S, E);
            } else {
                pg8::EpiResid<true> E{(bf16_t*)(ws + WS_HB), nullptr, P->out};
                pg8::gemm_phase<pg8::EpiResid<true>, pg8::StaticOrder, true, 2816>(ldsl, g, S, E);
            }
        }
        if (l == 0) GSYNC();
    }
}

extern "C" void kernel_launch(void* const* d_in, const int* in_sizes, int n_in, void* d_out, int out_size, void* d_ws, size_t ws_size, hipStream_t stream) {
    static int grid = 0;
    if (grid == 0) {
        if (n_in != 26 || ws_size < WS_END) { fprintf(stderr, "kernel_launch: need 26 inputs and %zu bytes of workspace (got %d, %zu)\n", (size_t)WS_END, n_in, ws_size); grid = -1; return; }
        int dev = 0, cus = 0, per_cu = 0;
        hipGetDevice(&dev);
        hipDeviceGetAttribute(&cus, hipDeviceAttributeMultiprocessorCount, dev);
        if (hipFuncSetAttribute((const void*)mega, hipFuncAttributeMaxDynamicSharedMemorySize, LDS_BYTES) != hipSuccess) { fprintf(stderr, "kernel_launch: hipFuncSetAttribute failed\n"); grid = -1; return; }
        hipOccupancyMaxActiveBlocksPerMultiprocessor(&per_cu, (const void*)mega, 512, LDS_BYTES);
        if (per_cu < 1) { fprintf(stderr, "kernel_launch: occupancy query says %d blocks per CU\n", per_cu); per_cu = 1; }
        (void)hipGetLastError();
        grid = cus * 1;
    }
    if (grid < 0) return;
    Params p{};
    for (int i = 0; i < 26; ++i) p.in[i] = (const float*)d_in[i];
    p.out = (float*)d_out; p.ws = (unsigned char*)d_ws;
    if (hipMemsetAsync((char*)d_ws + WS_BAR, 0, 16384, stream) != hipSuccess) { fprintf(stderr, "memset failed\n"); return; }
    void* args[] = {&p};
    hipError_t e = hipLaunchCooperativeKernel((const void*)mega, dim3(grid), dim3(512), args, LDS_BYTES, stream);
    if (e != hipSuccess) fprintf(stderr, "cooperative launch failed: %s (grid %d)\n", hipGetErrorString(e), grid);
}
```

```cpp
#include <hip/hip_runtime.h>
#include <hip/hip_cooperative_groups.h>
#include <cstdio>
#include <cstdint>
namespace cg = cooperative_groups;

#define DI __device__ __forceinline__
#define LAS __attribute__((address_space(3)))
typedef unsigned short bf16_t;
typedef short bf16x8 __attribute__((ext_vector_type(8)));
typedef float f32x4 __attribute__((ext_vector_type(4)));
typedef float f32x16 __attribute__((ext_vector_type(16)));
typedef float f32x2 __attribute__((ext_vector_type(2)));
typedef unsigned u32x4 __attribute__((ext_vector_type(4)));
typedef unsigned u32x2 __attribute__((ext_vector_type(2)));
typedef __bf16 bf16x2n __attribute__((ext_vector_type(2)));

constexpr int NT = 49152, NTP = 32768, DM = 1024, NIN = 1792, DFF = 2816, NFF2 = 5632;
constexpr int LDS_BYTES = 147456;
#ifndef PHM
#define PHM 0xFFFF
#endif
#ifndef REP_FFN
#define REP_FFN 1
#endif
#ifndef REP_HY
#define REP_HY 1
#endif
#ifndef REP_L1
#define REP_L1 1
#endif
#ifndef REP_L2
#define REP_L2 1
#endif
#ifndef REP_P0
#define REP_P0 1
#endif
constexpr float EPSV = 1e-6f;
constexpr float LOG2E = 1.4426950408889634f;

constexpr size_t WS_WIN = 0;
constexpr size_t WS_WOUT = WS_WIN + 2ull * 1792 * 1024 * 2;
constexpr size_t WS_WF1 = WS_WOUT + 2ull * 1024 * 1024 * 2;
constexpr size_t WS_WF2 = WS_WF1 + 2ull * 5632 * 1024 * 2;
constexpr size_t WS_HB = WS_WF2 + 2ull * 1024 * 2816 * 2;
constexpr int KRS_LEN = 2 * 16384 + 512, KRP_LEN = 2 * 4096 + 512, KR_PAD = 256;
constexpr size_t WS_KRS = WS_HB + (size_t)NT * 1024 * 2;
constexpr size_t WS_KRP = WS_KRS + 4ull * 256 * KRS_LEN * 2;
constexpr size_t WS_P = WS_KRP + 4ull * 256 * KRP_LEN * 2;
constexpr size_t WS_HY = WS_P + (size_t)NT * 1792 * 2;
constexpr size_t HY_ARR = (size_t)256 * NT;
constexpr size_t WS_ACT = WS_P;
constexpr size_t WS_BAR = WS_HY + 4 * HY_ARR * 2;
constexpr size_t WS_SS = WS_BAR + 16384;
constexpr size_t WS_END = WS_SS + 4ull * NT * 4;
static_assert(WS_ACT + (size_t)NT * 2816 * 2 <= WS_BAR, "act alias");

struct Params { const float* in[26]; float* out; unsigned char* ws; };
typedef const __attribute__((address_space(4))) Params* KP;

DI unsigned pk2(float lo, float hi) { f32x2 v = {lo, hi}; return __builtin_bit_cast(unsigned, __builtin_convertvector(v, bf16x2n)); }
DI float bflo(unsigned u) { return __uint_as_float(u << 16); }
DI float bfhi(unsigned u) { return __uint_as_float(u & 0xffff0000u); }
DI float bf2f(bf16_t v) { return __uint_as_float(((unsigned)v) << 16); }
DI bf16_t f2bf(float x) { return (bf16_t)(pk2(x, 0.f) & 0xffffu); }
DI void unpack8(const u32x4& r, float (&f)[8]) {
    f[0] = bflo(r.x); f[1] = bfhi(r.x); f[2] = bflo(r.y); f[3] = bfhi(r.y); f[4] = bflo(r.z); f[5] = bfhi(r.z); f[6] = bflo(r.w); f[7] = bfhi(r.w);
}
DI u32x4 pack8(const float (&f)[8]) { u32x4 w; w.x = pk2(f[0], f[1]); w.y = pk2(f[2], f[3]); w.z = pk2(f[4], f[5]); w.w = pk2(f[6], f[7]); return w; }
DI void seq_info(int tok, int& s0, int& L) { if (tok < NTP) { s0 = tok & ~4095; L = 4096; } else { s0 = NTP; L = 16384; } }
DI float wave_sum(float v) {
#pragma unroll
    for (int o = 1; o < 64; o <<= 1) v += __shfl_xor(v, o);
    return v;
}
DI float sin_rev(float rev) { return __builtin_amdgcn_sinf(__builtin_amdgcn_fractf(rev)); }
DI float cos_rev(float rev) { return __builtin_amdgcn_cosf(__builtin_amdgcn_fractf(rev)); }
DI float sin_rad(float x) { return sin_rev(x * 0.15915494309189535f); }
DI int opaque_v(int x) { asm volatile("" : "+v"(x)); return x; }
DI int opaque_s(int x) { asm volatile("" : "+s"(x)); return x; }
DI float gelu_f(float v) {
    const float av = fabsf(v), t = __builtin_amdgcn_rcpf(av * 0.2316418882f + 1.0f);
    float q = t * 0.5307027145f + (-0.7265760135f); q = q * t + 0.7107068705f; q = q * t + (-0.142248368f); q = q * t + 0.127414796f; q = q * t;
    const float e = __builtin_amdgcn_exp2f((v * v) * (-0.72134752044f));
    const float m = v * (q * e);
    return v < 0.f ? m : v - m;
}
DI int crow(int reg, int h) { return (reg & 3) + 8 * (reg >> 2) + 4 * h; }

namespace pg8 {
constexpr int BM = 256, BK = 64, HALF = 128, HTB = HALF * BK * 2, NXCD = 8, WGM = 8;
DI int lds_byte(int r, int c) { const int st = (r >> 4) * 2 + (c >> 5), rr = r & 15, cc = c & 31, ob = rr * 64 + cc * 2; return st * 1024 + (ob ^ (((ob >> 9) & 1) << 5)); }
DI void stage_rc(int b, int& R, int& C) { const int st = b / 1024, sb = b % 1024, swz = sb ^ (((sb >> 9) & 1) << 5); R = (st >> 1) * 16 + swz / 64; C = (st & 1) * 32 + (swz % 64) / 2; }
DI int perm32(int rho) { const int n = rho >> 4, i = rho & 15; return 8 * (i >> 2) + 4 * n + (i & 3); }

struct Unit { int pm, pn, arow; };
struct Gemm { const bf16_t* A; const bf16_t* Bt; int K; };

struct StaticOrder {
    int nM, nN, nwg, G, c;
    DI void init(int M, int N, int G_, int c_) { nM = M / BM; nN = N / BM; nwg = nM * nN; G = G_; c = c_; }
    DI bool next(int i, Unit& u) const {
        const long Lx = (long)i * G + c; if (Lx >= nwg) return false;
        int wgid = (int)Lx; { const int q = nwg / NXCD, r = nwg % NXCD, xcd = wgid % NXCD, off = wgid / NXCD; wgid = (xcd < r ? xcd * (q + 1) : r * (q + 1) + (xcd - r) * q) + off; }
        const int nig = WGM * nN, gid = wgid / nig, fm = gid * WGM, gsz = (nM - fm) < WGM ? (nM - fm) : WGM;
        u.pm = fm + ((wgid % nig) % gsz); u.pn = (wgid % nig) / gsz; u.arow = u.pm * BM; return true;
    }
};
struct OneUnit {
    Unit u;
    DI bool next(int i, Unit& o) const { if (i != 0) return false; o = u; return true; }
};

struct EpiBf16 {
    static constexpr bool AFTER_DRAIN = false, PREFETCH = false;
    bf16_t* O; int ldc; const float* ss;
    DI void operator()(const f32x4 (&acc)[2][2][4][2], const Unit& u, int wr, int wc, int fr, int fq) const {
        const int row0 = u.pm * BM + wr * 64 + fr, col0 = u.pn * BM + wc * 32 + 8 * fq;
#pragma unroll
        for (int ai = 0; ai < 2; ++ai)
#pragma unroll
            for (int m = 0; m < 4; ++m) {
                const int row = row0 + ai * HALF + m * 16;
                const float rs = rsqrtf(ss[row] * (1.0f / 1024.0f) + EPSV);
                bf16_t* rowp = O + (size_t)row * ldc + col0;
#pragma unroll
                for (int bj = 0; bj < 2; ++bj) {
                    const f32x4 v0 = acc[ai][bj][m][0] * rs, v1 = acc[ai][bj][m][1] * rs;
                    u32x4 w; w.x = pk2(v0[0], v0[1]); w.y = pk2(v0[2], v0[3]); w.z = pk2(v1[0], v1[1]); w.w = pk2(v1[2], v1[3]);
                    *(u32x4*)(rowp + bj * HALF) = w;
                }
            }
    }
    DI void fused(const f32x4 (&)[2][2][4][2], const Unit&, int, int, int, int, LAS unsigned char*, int) const {}
};
template <bool FINAL>
struct EpiResid {
    static constexpr bool AFTER_DRAIN = false, PREFETCH = false;
    bf16_t* XB; float* ss; float* out;
    DI void operator()(const f32x4 (&acc)[2][2][4][2], const Unit& u, int wr, int wc, int fr, int fq) const {
        const int row0 = u.pm * BM + wr * 64 + fr, col0 = u.pn * BM + wc * 32 + 8 * fq;
#pragma unroll
        for (int ai = 0; ai < 2; ++ai)
#pragma unroll
            for (int m = 0; m < 4; ++m) {
                const int row = row0 + ai * HALF + m * 16;
                bf16_t* xp = XB + (size_t)row * DM + col0;
                float sq = 0.f;
#pragma unroll
                for (int bj = 0; bj < 2; ++bj) {
                    const u32x4 r = *(const u32x4*)(xp + bj * HALF);
                    float f[8]; unpack8(r, f);
                    const f32x4 a0 = acc[ai][bj][m][0], a1 = acc[ai][bj][m][1];
                    f[0] += a0[0]; f[1] += a0[1]; f[2] += a0[2]; f[3] += a0[3]; f[4] += a1[0]; f[5] += a1[1]; f[6] += a1[2]; f[7] += a1[3];
                    if (FINAL) {
                        float* op = out + (size_t)row * DM + col0 + bj * HALF;
                        *(f32x4*)op = (f32x4){f[0], f[1], f[2], f[3]}; *(f32x4*)(op + 4) = (f32x4){f[4], f[5], f[6], f[7]};
                    } else {
#pragma unroll
                        for (int j = 0; j < 8; ++j) sq += f[j] * f[j];
                        *(u32x4*)(xp + bj * HALF) = pack8(f);
                    }
                }
                if (!FINAL) {
                    sq += __shfl_xor(sq, 16); sq += __shfl_xor(sq, 32);
                    if (fq == 0) atomicAdd(ss + row, sq);
                }
            }
    }
    DI void fused(const f32x4 (&)[2][2][4][2], const Unit&, int, int, int, int, LAS unsigned char*, int) const {}
};
struct EpiFfn {
    static constexpr bool AFTER_DRAIN = true, PREFETCH = false;
    bf16_t* act; const float* cw; const float* cb; int tok0, jlo, jhi;
    DI void operator()(const f32x4 (&)[2][2][4][2], const Unit&, int, int, int, int) const {}
    DI void fused(const f32x4 (&acc)[2][2][4][2], const Unit& u, int wr, int wc, int fr, int fq, LAS unsigned char* lds, int tid) const {
        constexpr int TS = 528;
#pragma unroll
        for (int ai = 0; ai < 2; ++ai)
#pragma unroll
            for (int m = 0; m < 4; ++m) {
                const int row = ai * HALF + wr * 64 + m * 16 + fr;
#pragma unroll
                for (int bj = 0; bj < 2; ++bj) {
                    const f32x4 v0 = acc[ai][bj][m][0], v1 = acc[ai][bj][m][1];
                    u32x4 w; w.x = pk2(v0[0], v0[1]); w.y = pk2(v0[2], v0[3]); w.z = pk2(v1[0], v1[1]); w.w = pk2(v1[2], v1[3]);
                    *(LAS u32x4*)(lds + row * TS + (bj * HALF + wc * 32 + 8 * fq) * 2) = w;
                }
            }
        __syncthreads();
        const int c8 = (tid & 15) * 8, rg = tid >> 4;
        const int gcol = u.pn * 128 + c8, ucol = DFF + gcol;
        float wg[3][8], wu[3][8], bg[8], bu[8];
#pragma unroll
        for (int k = 0; k < 3; ++k)
#pragma unroll
            for (int j = 0; j < 8; ++j) { wg[k][j] = cw[k * NFF2 + gcol + j]; wu[k][j] = cw[k * NFF2 + ucol + j]; }
#pragma unroll
        for (int j = 0; j < 8; ++j) { bg[j] = cb[gcol + j]; bu[j] = cb[ucol + j]; }
        float pg[8], pu[8], cg_[8], cu[8], ng[8], nu[8];
        const int r0 = rg * 8;
        {
            u32x4 a = {0, 0, 0, 0}, b = {0, 0, 0, 0};
            if (r0 > 0) { a = *(const LAS u32x4*)(lds + (r0 - 1) * TS + c8 * 2); b = *(const LAS u32x4*)(lds + (r0 - 1) * TS + (128 + c8) * 2); }
            unpack8(a, pg); unpack8(b, pu);
            a = *(const LAS u32x4*)(lds + r0 * TS + c8 * 2); b = *(const LAS u32x4*)(lds + r0 * TS + (128 + c8) * 2);
            unpack8(a, cg_); unpack8(b, cu);
        }
#pragma unroll
        for (int i = 0; i < 8; ++i) {
            const int r = r0 + i;
            u32x4 a = {0, 0, 0, 0}, b = {0, 0, 0, 0};
            if (r < 255) { a = *(const LAS u32x4*)(lds + (r + 1) * TS + c8 * 2); b = *(const LAS u32x4*)(lds + (r + 1) * TS + (128 + c8) * 2); }
            unpack8(a, ng); unpack8(b, nu);
            if (r >= jlo && r <= jhi) {
                float o[8];
#pragma unroll
                for (int j = 0; j < 8; ++j) {
                    const float g = pg[j] * wg[0][j] + cg_[j] * wg[1][j] + ng[j] * wg[2][j] + bg[j];
                    const float up = pu[j] * wu[0][j] + cu[j] * wu[1][j] + nu[j] * wu[2][j] + bu[j];
                    o[j] = gelu_f(g) * up;
                }
                *(u32x4*)(act + (size_t)(tok0 + r) * DFF + gcol) = pack8(o);
            }
#pragma unroll
            for (int j = 0; j < 8; ++j) { pg[j] = cg_[j]; pu[j] = cu[j]; cg_[j] = ng[j]; cu[j] = nu[j]; }
        }
        __syncthreads();
    }
};

constexpr int FFN_MT = 136 + 67, FFN_UNITS = FFN_MT * 22;
DI void ffn_decode(int mt, int& s0, int& L, int& ti) { if (mt < 136) { s0 = (mt / 17) * 4096; ti = mt % 17; L = 4096; } else { s0 = NTP; ti = mt - 136; L = 16384; } }
struct FfnOrder {
    int G, vb;
    DI bool next(int i, Unit& u) const {
        const int t = i * G + vb; if (t >= FFN_UNITS) return false;
        int mt, pn;
        constexpr int BS = 6, NFULL = 22 / BS, REM = 22 - NFULL * BS;
        if (t < NFULL * BS * FFN_MT) { const int blk = t / (BS * FFN_MT), r = t % (BS * FFN_MT); mt = r / BS; pn = blk * BS + r % BS; }
        else { const int r = t - NFULL * BS * FFN_MT; mt = r / REM; pn = NFULL * BS + r % REM; }
        int s0, L, ti; ffn_decode(mt, s0, L, ti);
        u.pm = mt; u.pn = pn; u.arow = s0 + 248 * ti - 1; return true;
    }
};
DI f32x4 dpp_rot(const f32x4& v, bool one) {
    f32x4 r;
#pragma unroll
    for (int j = 0; j < 4; ++j) {
        const int x = __float_as_int(v[j]);
        r[j] = __int_as_float(one ? __builtin_amdgcn_update_dpp(0, x, 0x121, 0xf, 0xf, true) : __builtin_amdgcn_update_dpp(0, x, 0x12F, 0xf, 0xf, true));
    }
    return r;
}
DI f32x4 sel4(bool c, const f32x4& a, const f32x4& b) { f32x4 r; r[0] = c ? a[0] : b[0]; r[1] = c ? a[1] : b[1]; r[2] = c ? a[2] : b[2]; r[3] = c ? a[3] : b[3]; return r; }
struct EpiFfnReg {
    static constexpr bool AFTER_DRAIN = false, PREFETCH = true;
    static constexpr int XOFF = 131072;
    bf16_t* act; const float* cw; const float* cb; const float* ss;
    DI void prefetch(const Unit& u, LAS unsigned char* lds, int wid, int lane, int buf) const {
        if (wid < 4) {
            const int a = 2 * wid + (lane >> 5), k = a & 3;
            const float* src = (k < 3 ? cw + (size_t)k * NFF2 : cb) + (a >= 4 ? DFF : 0) + u.pn * 128 + (lane & 31) * 4;
            __builtin_amdgcn_global_load_lds((const unsigned*)src, (LAS unsigned*)(lds + XOFF + buf * 4096 + wid * 1024), 16, 0, 0);
        } else if (wid == 4) {
            int s0, L, ti; ffn_decode(u.pm, s0, L, ti);
            const int start = (s0 + 248 * ti - 1) & ~3;
            __builtin_amdgcn_global_load_lds((const unsigned*)(ss + start + lane * 4), (LAS unsigned*)(lds + XOFF + 8192 + buf * 1024), 16, 0, 0);
        }
    }
    DI void operator()(const f32x4 (&)[2][2][4][2], const Unit&, int, int, int, int) const {}
    DI void run(const f32x4 (&acc)[2][2][4][2], const Unit& u, int wr, int wc, int fr, int fq, LAS unsigned char* lds, int buf) const {
        int s0, L, ti; ffn_decode(u.pm, s0, L, ti);
        const LAS float* wl = (const LAS float*)(lds + XOFF + buf * 4096);
        const LAS float* sl = (const LAS float*)(lds + XOFF + 8192 + buf * 1024) - ((s0 + 248 * ti - 1) & ~3);
        float rsv[2][4];
#pragma unroll
        for (int ai = 0; ai < 2; ++ai)
#pragma unroll
            for (int m = 0; m < 4; ++m) { int p_ = 248 * ti + 62 * (2 * ai + wr) - 1 + 16 * m + fr; p_ = p_ < 0 ? 0 : (p_ > L - 1 ? L - 1 : p_); rsv[ai][m] = __builtin_amdgcn_rsqf(sl[s0 + p_] * (1.0f / 1024.0f) + EPSV); }
        const int gcol = u.pn * 128 + wc * 32 + 8 * fq;
        const bool is15 = (fr == 15), is0 = (fr == 0);
#pragma unroll
        for (int n = 0; n < 2; ++n) {
            const int gc = gcol + 4 * n, lc = wc * 32 + 8 * fq + 4 * n;
            const f32x4 wg0 = *(const LAS f32x4*)(wl + lc), wg1 = *(const LAS f32x4*)(wl + 128 + lc), wg2 = *(const LAS f32x4*)(wl + 256 + lc), bgv = *(const LAS f32x4*)(wl + 384 + lc);
            const f32x4 wu0 = *(const LAS f32x4*)(wl + 512 + lc), wu1 = *(const LAS f32x4*)(wl + 640 + lc), wu2 = *(const LAS f32x4*)(wl + 768 + lc), buv = *(const LAS f32x4*)(wl + 896 + lc);
#pragma unroll
            for (int ai = 0; ai < 2; ++ai) {
                const int posb = 248 * ti + 62 * (2 * ai + wr) - 1;
                f32x4 sg[4], su[4];
#pragma unroll
                for (int m = 0; m < 4; ++m) { sg[m] = acc[ai][0][m][n] * rsv[ai][m]; su[m] = acc[ai][1][m][n] * rsv[ai][m]; }
#pragma unroll
                for (int m = 0; m < 4; ++m) {
                    const int rho = 16 * m + fr, pos = posb + rho;
                    const f32x4 xg = sg[m], xu = su[m];
                    const f32x4 zpg = (m > 0) ? sel4(is15, sg[m > 0 ? m - 1 : 0], xg) : xg;
                    const f32x4 zpu = (m > 0) ? sel4(is15, su[m > 0 ? m - 1 : 0], xu) : xu;
                    const f32x4 zng = (m < 3) ? sel4(is0, sg[m < 3 ? m + 1 : 3], xg) : xg;
                    const f32x4 znu = (m < 3) ? sel4(is0, su[m < 3 ? m + 1 : 3], xu) : xu;
                    const f32x4 pg = dpp_rot(zpg, true), pu = dpp_rot(zpu, true), ng = dpp_rot(zng, false), nu = dpp_rot(znu, false);
                    f32x4 g = pg * wg0 + xg * wg1 + ng * wg2 + bgv;
                    f32x4 up = pu * wu0 + xu * wu1 + nu * wu2 + buv;
                    if (posb + 16 * m <= 0 && posb + 16 * m + 15 >= 0) { if (pos == 0) { g = xg * wg1 + ng * wg2 + bgv; up = xu * wu1 + nu * wu2 + buv; } }
                    if (posb + 16 * m <= L - 1 && posb + 16 * m + 15 >= L - 1) { if (pos == L - 1) { g = g - ng * wg2; up = up - nu * wu2; } }
                    if (rho >= 1 && rho <= 62 && pos < L) {
                        u32x2 ov; ov.x = pk2(gelu_f(g[0]) * up[0], gelu_f(g[1]) * up[1]); ov.y = pk2(gelu_f(g[2]) * up[2], gelu_f(g[3]) * up[3]);
                        *(u32x2*)(act + (size_t)(s0 + pos) * DFF + gc) = ov;
                    }
                }
            }
        }
    }
    DI void fused(const f32x4 (&)[2][2][4][2], const Unit&, int, int, int, int, LAS unsigned char*, int) const {}
};

template <class Epi, class Sched, bool ALIGN_EPI, int KDIM, int SEG = 64>
DI void gemm_phase(LAS unsigned char* lds, const Gemm g, const Sched& S, const Epi& E) {
    const int tid = opaque_v(threadIdx.x), wid = __builtin_amdgcn_readfirstlane(tid >> 6), lane = tid & 63, wr = wid >> 2, wc = wid & 3, fr = lane & 15, fq = lane >> 4;
    constexpr int K = KDIM, nt = K / BK;
    unsigned voffA[2], voffB[2];
#pragma unroll
    for (int i = 0; i < 2; ++i) { int R, C; stage_rc(tid * 16 + i * 8192, R, C); const int Rb = (R & ~31) + perm32(R & 31);
        voffA[i] = (unsigned)((SEG * (R >> 6) + (R & 63)) * K + C) * 2u; voffB[i] = (unsigned)(Rb * K + C) * 2u; }
    constexpr size_t kstep = (size_t)(BK * 2);
    constexpr size_t hstep = (size_t)HALF * K * 2;
    constexpr size_t hstepA = (size_t)(2 * SEG) * K * 2;
    constexpr size_t tstep = 2 * hstep;
    constexpr size_t rstep = (size_t)K * 2;
    const unsigned ldsw = (unsigned)wid * 1024u;
    const int aoff = lds_byte(wr * 64 + fr, fq * 8), boff = lds_byte(wc * 32 + fr, fq * 8);
#define G_SA(b, h) (((b) * 2 + (h)) * HTB)
#define G_SB(b, h) ((4 + (b) * 2 + (h)) * HTB)
#define G_STAGE(bufoff, gbase, voff) do { _Pragma("unroll") for (int _i = 0; _i < 2; ++_i) \
        __builtin_amdgcn_global_load_lds((const unsigned*)((const char*)(gbase) + (voff)[_i]), (LAS unsigned*)(lds + (bufoff) + ldsw + _i * 8192), 16, 0, 0); } while (0)
#define G_LDA(dst, b, h) do { _Pragma("unroll") for (int m = 0; m < 4; ++m) _Pragma("unroll") for (int k = 0; k < 2; ++k) dst[m][k] = *(const LAS bf16x8*)(lds + G_SA(b, h) + aoff + m * 2048 + k * 1024); } while (0)
#define G_LDB(dst, b, h) do { _Pragma("unroll") for (int n = 0; n < 2; ++n) _Pragma("unroll") for (int k = 0; k < 2; ++k) dst[n][k] = *(const LAS bf16x8*)(lds + G_SB(b, h) + boff + n * 2048 + k * 1024); } while (0)
#define G_MMA(ai, bj, At, Bt) do { __builtin_amdgcn_s_setprio(1); _Pragma("unroll") for (int m = 0; m < 4; ++m) _Pragma("unroll") for (int n = 0; n < 2; ++n) _Pragma("unroll") for (int k = 0; k < 2; ++k) \
        acc[ai][bj][m][n] = __builtin_amdgcn_mfma_f32_16x16x32_bf16(Bt[n][k], At[m][k], acc[ai][bj][m][n], 0, 0, 0); __builtin_amdgcn_s_setprio(0); } while (0)
#define G_WAIT_V(n) asm volatile("s_waitcnt vmcnt(" #n ")" ::: "memory")
#define G_WAIT_L(n) asm volatile("s_waitcnt lgkmcnt(" #n ")" ::: "memory")
#define G_BAR __builtin_amdgcn_s_barrier()
#define G_SCHED __builtin_amdgcn_sched_barrier(0)
    Unit cur, nxt; int ui = 0;
    if (!S.next(0, cur)) return;
    f32x4 acc[2][2][4][2];
#pragma unroll
    for (int a = 0; a < 2; ++a)
#pragma unroll
        for (int b = 0; b < 2; ++b)
#pragma unroll
            for (int m = 0; m < 4; ++m)
#pragma unroll
                for (int n = 0; n < 2; ++n) acc[a][b][m][n] = (f32x4){0.f, 0.f, 0.f, 0.f};
    bf16x8 At[4][2], B0[2][2], B1[2][2];
    const char* cA = (const char*)g.A + (size_t)cur.arow * rstep; const char* cB = (const char*)g.Bt + (size_t)cur.pn * tstep;
    if constexpr (Epi::PREFETCH) E.prefetch(cur, lds, wid, lane, 0);
    G_STAGE(G_SB(0, 0), cB, voffB); G_STAGE(G_SB(0, 1), cB + hstep, voffB); G_STAGE(G_SA(0, 0), cA, voffA); G_STAGE(G_SA(0, 1), cA + hstepA, voffA);
    if (wr == 1) G_BAR;
    G_WAIT_V(2); G_BAR;
    G_STAGE(G_SB(1, 0), cB + kstep, voffB); G_STAGE(G_SA(1, 0), cA + kstep, voffA); G_STAGE(G_SB(1, 1), cB + hstep + kstep, voffB);
    G_WAIT_V(6); G_BAR;
    for (;;) {
        const bool has_next = S.next(ui + 1, nxt);
        const char* nA = has_next ? (const char*)g.A + (size_t)nxt.arow * rstep : cA; const char* nB = has_next ? (const char*)g.Bt + (size_t)nxt.pn * tstep : cB;
        for (int t = 0; t < nt; t += 2) {
            const bool last = (t == nt - 2);
            const char* a1 = cA + (size_t)(t + 1) * kstep;
            const char* a2 = last ? nA : cA + (size_t)(t + 2) * kstep; const char* b2 = last ? nB : cB + (size_t)(t + 2) * kstep;
            const char* a3 = a2 + kstep; const char* b3 = b2 + kstep;
            G_LDB(B0, 0, 0); G_LDB(B1, 0, 1); G_SCHED; G_LDA(At, 0, 0); G_STAGE(G_SA(1, 1), a1 + hstepA, voffA);
            G_WAIT_V(8); G_WAIT_L(0); G_BAR; G_MMA(0, 0, At, B0); G_MMA(0, 1, At, B1); G_BAR; G_SCHED;
            G_LDA(At, 0, 1); G_STAGE(G_SB(0, 0), b2, voffB); G_STAGE(G_SB(0, 1), b2 + hstep, voffB); G_STAGE(G_SA(0, 0), a2, voffA);
            G_WAIT_V(8); G_WAIT_L(0); G_BAR; G_MMA(1, 0, At, B0); G_MMA(1, 1, At, B1); G_BAR; G_SCHED;
            G_LDB(B0, 1, 0); G_LDB(B1, 1, 1); G_SCHED; G_LDA(At, 1, 0); G_STAGE(G_SA(0, 1), a2 + hstepA, voffA);
            G_WAIT_V(8); G_WAIT_L(0); G_BAR; G_MMA(0, 0, At, B0); G_MMA(0, 1, At, B1); G_BAR; G_SCHED;
            G_LDA(At, 1, 1); G_STAGE(G_SB(1, 0), b3, voffB); G_STAGE(G_SB(1, 1), b3 + hstep, voffB); G_STAGE(G_SA(1, 0), a3, voffA);
            G_WAIT_V(8); G_WAIT_L(0); G_BAR; G_MMA(1, 0, At, B0); G_MMA(1, 1, At, B1); G_BAR; G_SCHED;
        }
        if constexpr (ALIGN_EPI) { if (wr == 0) G_BAR; }
        if constexpr (!Epi::AFTER_DRAIN) { if constexpr (Epi::PREFETCH) { E.run(acc, cur, wr, wc, fr, fq, lds, ui & 1); if (has_next) E.prefetch(nxt, lds, wid, lane, (ui + 1) & 1); } else E(acc, cur, wr, wc, fr, fq); }
        if (!has_next) break;
#pragma unroll
        for (int a = 0; a < 2; ++a)
#pragma unroll
            for (int b = 0; b < 2; ++b)
#pragma unroll
                for (int m = 0; m < 4; ++m)
#pragma unroll
                    for (int n = 0; n < 2; ++n) acc[a][b][m][n] = (f32x4){0.f, 0.f, 0.f, 0.f};
        cur = nxt; cA = nA; cB = nB; ++ui;
        if constexpr (ALIGN_EPI) { if (wr == 1) G_BAR; }
    }
    G_WAIT_V(0);
    if constexpr (!ALIGN_EPI) { if (wr == 0) G_BAR; }
    G_BAR;
    if constexpr (Epi::AFTER_DRAIN) { E.fused(acc, cur, wr, wc, fr, fq, lds, tid); }
#undef G_SA
#undef G_SB
#undef G_STAGE
#undef G_LDA
#undef G_LDB
#undef G_MMA
#undef G_WAIT_V
#undef G_WAIT_L
#undef G_BAR
#undef G_SCHED
}
}


#define XB_TMO      128
#define XB_XCNT(j)  (256  + 64 * (j))
#define XB_XSUB(j)  (1280 + 64 * (j))
#define XB_XGEN(j)  (2304 + 64 * (j))
#define XB_TOP      3328
#define XB_TOPGEN   3392
#define XCD_BAR_WORDS 3456
#define XB_SPIN_CAP (1u << 18)
DI unsigned xb_ld(unsigned* p)              { return __hip_atomic_load(p, __ATOMIC_RELAXED, __HIP_MEMORY_SCOPE_AGENT); }
DI unsigned xb_add(unsigned* p, unsigned v) { return __hip_atomic_fetch_add(p, v, __ATOMIC_RELAXED, __HIP_MEMORY_SCOPE_AGENT); }
DI unsigned xb_xcc_id() { return (unsigned)__builtin_amdgcn_s_getreg((3 << 11) | 20) & 0xFu; }
#define XB_SPIN(cond, bar) do { unsigned _sp = 0; while (cond) { __builtin_amdgcn_s_sleep(1); \
    if ((++_sp & 255u) == 0u) { if (xb_ld(&(bar)[XB_TMO])) break; if (_sp > XB_SPIN_CAP) { atomicAdd(&(bar)[XB_TMO], 1u); break; } } } } while (0)
struct XcdBarrier { unsigned* bar; unsigned x; volatile LAS unsigned* st; };
DI XcdBarrier xcd_barrier_post(unsigned* bar, volatile LAS unsigned* st) {
    XcdBarrier b; b.bar = bar; b.x = xb_xcc_id(); b.st = st;
    if (threadIdx.x == 0) (void)xb_add(&bar[XB_XCNT(b.x)], 1u);
    return b;
}
DI void xcd_barrier_complete(unsigned* bar, unsigned x, unsigned& nloc, unsigned& nx) {
    const unsigned G = gridDim.x * gridDim.y * gridDim.z;
    unsigned sum, cnt, mine, sp = 0u;
    for (;;) {
        sum = 0u; cnt = 0u; mine = 0u;
#pragma unroll
        for (unsigned j = 0; j < 16; ++j) { const unsigned c = xb_ld(&bar[XB_XCNT(j)]); sum += c; cnt += (c > 0u) ? 1u : 0u; mine = (j == x) ? c : mine; }
        if (sum == G) break;
        __builtin_amdgcn_s_sleep(1);
        if ((++sp & 255u) == 0u) { if (xb_ld(&bar[XB_TMO])) break; if (sp > XB_SPIN_CAP) { atomicAdd(&bar[XB_TMO], 1u); break; } }
    }
    nloc = mine > 0u ? mine : 1u; nx = cnt > 0u ? cnt : 1u;
}
DI void xcd_barrier(const XcdBarrier& b) {
    asm volatile("s_waitcnt vmcnt(0)" ::: "memory");
    __syncthreads();
    if (threadIdx.x == 0) {
        unsigned* bar = b.bar;
        asm volatile("" : "+s"(bar));
        unsigned bx = b.x; asm volatile("" : "+s"(bx));
        __builtin_amdgcn_s_waitcnt(0);
        unsigned nloc = b.st[0], nx = b.st[1];
        if (nloc == 0u) { xcd_barrier_complete(bar, bx, nloc, nx); b.st[0] = nloc; b.st[1] = nx; }
        const unsigned old = xb_add(&bar[XB_XSUB(bx)], 1u);
        const unsigned gen = old / nloc;
        if (old + 1u == (gen + 1u) * nloc) {
            __builtin_amdgcn_fence(__ATOMIC_RELEASE, "agent");
            asm volatile("s_waitcnt vmcnt(0)" ::: "memory");
            const unsigned og = xb_add(&bar[XB_TOP], 1u);
            const unsigned tg = og / nx;
            if (og + 1u == (tg + 1u) * nx) xb_add(&bar[XB_TOPGEN], 1u);
            else XB_SPIN(xb_ld(&bar[XB_TOPGEN]) == tg, bar);
            __builtin_amdgcn_fence(__ATOMIC_ACQUIRE, "agent");
            xb_add(&bar[XB_XGEN(bx)], 1u);
            asm volatile("s_waitcnt vmcnt(0)" ::: "memory");
        } else {
            XB_SPIN(xb_ld(&bar[XB_XGEN(bx)]) == gen, bar);
            __builtin_amdgcn_fence(__ATOMIC_ACQUIRE, "agent");
            asm volatile("s_waitcnt vmcnt(0)" ::: "memory");
        }
    }
    __syncthreads();
}

struct TrTile { const float* src; bf16_t* dst; const float* gk; int N, K; };
DI TrTile tr_decode(KP P, unsigned char* ws, int u) {
    const int l = u / 2816, t = u % 2816;
    const float* W; bf16_t* Wt; const float* gv = nullptr; int K, N, tile; bool perm = false;
    if (t < 448) { W = P->in[3] + (size_t)l * 1024 * 1792; K = 1024; N = 1792; Wt = (bf16_t*)(ws + WS_WIN) + (size_t)l * 1792 * 1024; tile = t; gv = P->in[2] + l * 1024; }
    else if (t < 704) { W = P->in[20] + (size_t)l * 1024 * 1024; K = 1024; N = 1024; Wt = (bf16_t*)(ws + WS_WOUT) + (size_t)l * 1024 * 1024; tile = t - 448; }
    else if (t < 2112) { W = P->in[22] + (size_t)l * 1024 * 5632; K = 1024; N = 5632; Wt = (bf16_t*)(ws + WS_WF1) + (size_t)l * 5632 * 1024; tile = t - 704; perm = true; gv = P->in[21] + l * 1024; }
    else { W = P->in[25] + (size_t)l * 2816 * 1024; K = 2816; N = 1024; Wt = (bf16_t*)(ws + WS_WF2) + (size_t)l * 1024 * 2816; tile = t - 2112; }
    const int nk = K / 64, ntile = tile / nk, kt = tile % nk, n0 = ntile * 64, k0 = kt * 64;
    int sn0 = n0;
    if (perm) { const int pn = n0 >> 8, j = n0 & 255; sn0 = (j < 128) ? pn * 128 + j : DFF + pn * 128 + (j - 128); }
    TrTile r; r.src = W + (size_t)k0 * N + sn0; r.dst = Wt + (size_t)n0 * K + k0; r.gk = gv ? gv + k0 : nullptr; r.N = N; r.K = K; return r;
}
DI void transpose_group(KP P, unsigned char* ws, int grp, unsigned char* lds, int tid_) {
    const int tid = opaque_v(tid_);
    float* T = (float*)lds;
    f32x4 v[4][2];
#pragma unroll
    for (int j = 0; j < 4; ++j) {
        const TrTile t = tr_decode(P, ws, grp * 4 + j);
#pragma unroll
        for (int ps = 0; ps < 2; ++ps) { const int r = (tid >> 4) + 32 * ps, c4 = (tid & 15) * 4; v[j][ps] = *(const f32x4*)(t.src + (size_t)r * t.N + c4); if (t.gk) v[j][ps] = v[j][ps] * t.gk[r]; }
    }
#pragma unroll
    for (int j = 0; j < 4; ++j)
#pragma unroll
        for (int ps = 0; ps < 2; ++ps) { const int r = (tid >> 4) + 32 * ps, c4 = (tid & 15) * 4; float* Tj = T + j * 4160;
            Tj[(c4 + 0) * 65 + r] = v[j][ps][0]; Tj[(c4 + 1) * 65 + r] = v[j][ps][1]; Tj[(c4 + 2) * 65 + r] = v[j][ps][2]; Tj[(c4 + 3) * 65 + r] = v[j][ps][3]; }
    __syncthreads();
#pragma unroll
    for (int j = 0; j < 4; ++j) {
        const TrTile t = tr_decode(P, ws, grp * 4 + j);
        const int n = tid >> 3, kc = (tid & 7) * 8; const float* Tj = T + j * 4160;
        float f[8];
#pragma unroll
        for (int q = 0; q < 8; ++q) f[q] = Tj[n * 65 + kc + q];
        *(u32x4*)(t.dst + (size_t)n * t.K + kc) = pack8(f);
    }
    __syncthreads();
}

DI void xb_rows(const float* src0, const float* src1, bf16_t* XB, float* SS, int tid_, int bid, int G) {
    const int tid = opaque_v(tid_);
    const int w = tid >> 6, lane = tid & 63;
    for (int i = bid * 512 + tid; i < 3 * NT; i += G * 512) SS[NT + i] = 0.f;
    const int stride = G * 8;
    for (int row = bid * 8 + w; row < NT; row += 2 * stride) {
        const int row2 = row + stride; const bool has2 = row2 < NT;
        const float* sp = (row < NTP) ? src0 + (size_t)row * DM : src1 + (size_t)(row - NTP) * DM;
        const int r2 = has2 ? row2 : row;
        const float* sp2 = (r2 < NTP) ? src0 + (size_t)r2 * DM : src1 + (size_t)(r2 - NTP) * DM;
        f32x4 v[4], v2[4]; float ss = 0.f, ss2 = 0.f;
#pragma unroll
        for (int j = 0; j < 4; ++j) { v[j] = *(const f32x4*)(sp + j * 256 + lane * 4); v2[j] = *(const f32x4*)(sp2 + j * 256 + lane * 4); }
#pragma unroll
        for (int j = 0; j < 4; ++j) { ss += v[j][0] * v[j][0] + v[j][1] * v[j][1] + v[j][2] * v[j][2] + v[j][3] * v[j][3];
            ss2 += v2[j][0] * v2[j][0] + v2[j][1] * v2[j][1] + v2[j][2] * v2[j][2] + v2[j][3] * v2[j][3]; }
        ss = wave_sum(ss); ss2 = wave_sum(ss2);
#pragma unroll
        for (int j = 0; j < 4; ++j) {
            u32x2 o; o.x = pk2(v[j][0], v[j][1]); o.y = pk2(v[j][2], v[j][3]);
            *(u32x2*)(XB + (size_t)row * DM + j * 256 + lane * 4) = o;
        }
        if (lane == 0) SS[row] = ss;
        if (has2) {
#pragma unroll
            for (int j = 0; j < 4; ++j) {
                u32x2 o; o.x = pk2(v2[j][0], v2[j][1]); o.y = pk2(v2[j][2], v2[j][3]);
                *(u32x2*)(XB + (size_t)row2 * DM + j * 256 + lane * 4) = o;
            }
            if (lane == 0) SS[row2] = ss2;
        }
    }
}

DI void filter_tile(KP P, int l, int kind, int tile, unsigned char* lds, int tid_) {
    const int tid = opaque_v(tid_);
    const int L = kind ? 4096 : 16384, KRL = kind ? KRP_LEN : KRS_LEN;
    bf16_t* KR = (bf16_t*)(P->ws + (kind ? WS_KRP : WS_KRS)) + (size_t)l * 2 * 256 * KRL;
    const float* w1 = P->in[11] + l * 33 * 64; const float* b1 = P->in[12] + l * 64; const float* f1 = P->in[13] + l * 64;
    const float* w2 = P->in[14] + l * 64 * 64; const float* b2 = P->in[15] + l * 64; const float* f2 = P->in[16] + l * 64;
    const float* w3 = P->in[17] + (size_t)l * 64 * 1024; const float* hb = P->in[18] + l * 2 * 256;
    float* Z = (float*)lds;
    float* H1 = Z + 64 * 33;
    float* H2 = H1 + 64 * 64;
    bf16_t* OUT = (bf16_t*)(H2 + 64 * 64);
    const int t0 = tile * 64;
    for (int idx = tid; idx < 64 * 33; idx += 512) {
        const int t = idx / 33, e = idx % 33, n = t0 + t;
        float v;
        if (e == 0) v = (float)n / (float)(L - 1);
        else {
            const int bi = (e - 1) & 15;
            const float band = 1e-4f + (float)bi * ((15.0f - 1e-4f) / 15.0f);
            const float rev = (float)n * band / (float)L;
            v = (e <= 16) ? cos_rev(rev) : -sin_rev(rev);
        }
        Z[idx] = v;
    }
    __syncthreads();
    {
        const int j = tid & 63, tg = tid >> 6;
        float a[8];
#pragma unroll
        for (int i = 0; i < 8; ++i) a[i] = b1[j];
        for (int e = 0; e < 33; ++e) { const float w = w1[e * 64 + j];
#pragma unroll
            for (int i = 0; i < 8; ++i) a[i] += Z[(tg * 8 + i) * 33 + e] * w; }
        const float fr = f1[j];
#pragma unroll
        for (int i = 0; i < 8; ++i) H1[(tg * 8 + i) * 64 + j] = sin_rad(fr * a[i]);
    }
    __syncthreads();
    {
        const int j = tid & 63, tg = tid >> 6;
        float a[8];
#pragma unroll
        for (int i = 0; i < 8; ++i) a[i] = b2[j];
        for (int e = 0; e < 64; ++e) { const float w = w2[e * 64 + j];
#pragma unroll
            for (int i = 0; i < 8; ++i) a[i] += H1[(tg * 8 + i) * 64 + e] * w; }
        const float fr = f2[j];
#pragma unroll
        for (int i = 0; i < 8; ++i) H2[(tg * 8 + i) * 64 + j] = sin_rad(fr * a[i]);
    }
    __syncthreads();
    const int w = tid >> 6, lane = tid & 63, n = lane & 31, h = lane >> 5;
    bf16x8 afrag[2][4];
#pragma unroll
    for (int mb = 0; mb < 2; ++mb)
#pragma unroll
        for (int ks = 0; ks < 4; ++ks) {
            const float* hp = H2 + (mb * 32 + n) * 64 + ks * 16 + 8 * h;
            const f32x4 x0 = *(const f32x4*)hp, x1 = *(const f32x4*)(hp + 4);
            u32x4 pw; pw.x = pk2(x0[0], x0[1]); pw.y = pk2(x0[2], x0[3]); pw.z = pk2(x1[0], x1[1]); pw.w = pk2(x1[2], x1[3]);
            afrag[mb][ks] = __builtin_bit_cast(bf16x8, pw);
        }
    const int c = w * 32 + n;
    const float min_decay = -4.605170185988091f / 1.5f, max_decay = -4.605170185988091f / 0.3f;
    const float delta = fabsf(min_decay + (float)c * ((max_decay - min_decay) / 255.0f));
    for (int f = 0; f < 4; ++f) {
        f32x16 acc[2];
#pragma unroll
        for (int mb = 0; mb < 2; ++mb)
#pragma unroll
            for (int i = 0; i < 16; ++i) acc[mb][i] = 0.f;
#pragma unroll
        for (int ks = 0; ks < 4; ++ks) {
            const float* wp = w3 + (size_t)(ks * 16 + 8 * h) * 1024 + f * 256 + c;
            float wv[8];
#pragma unroll
            for (int j = 0; j < 8; ++j) wv[j] = wp[j * 1024];
            const bf16x8 bfrag = __builtin_bit_cast(bf16x8, pack8(wv));
#pragma unroll
            for (int mb = 0; mb < 2; ++mb) acc[mb] = __builtin_amdgcn_mfma_f32_32x32x16_bf16(afrag[mb][ks], bfrag, acc[mb], 0, 0, 0);
        }
#pragma unroll
        for (int mb = 0; mb < 2; ++mb)
#pragma unroll
            for (int i = 0; i < 16; ++i) {
                const int t = mb * 32 + crow(i, h);
                const float tn = (float)(t0 + t) / (float)(L - 1);
                float v = acc[mb][i] * __expf(-tn * delta);
                if ((f & 1) == 0 && (t0 + t) == 0) v += hb[(f >> 1) * 256 + c];
                OUT[c * 72 + t] = f2bf(v);
            }
        __syncthreads();
        const int o = f >> 1;
        for (int item = tid; item < 256 * 64; item += 512) {
            const int cc = item >> 6, t = item & 63, nn = t0 + t;
            bf16_t* arr = KR + (size_t)(o * 256 + cc) * KRL;
            const bf16_t v = OUT[cc * 72 + t];
            if ((f & 1) == 0) arr[KR_PAD + L - nn] = v;
            else if (nn > 0) arr[KR_PAD + L + nn] = v;
        }
        __syncthreads();
    }
}

DI void attn_unit(KP P, int l, int unit, unsigned char* lds, int tid_) {
    const int tid = opaque_v(tid_);
    const unsigned z0_ = (unsigned)opaque_v(0); const u32x4 zero4 = {z0_, z0_, z0_, z0_};
    const bf16_t* Pm = (const bf16_t*)(P->ws + WS_P);
    bf16_t* HB = (bf16_t*)(P->out);
    const int qb = unit >> 1, g = unit & 1;
    const int tokq0 = qb * 128; int s0, L; seq_info(tokq0, s0, L);
    const int pos0 = tokq0 - s0;
    bf16_t* Kl = (bf16_t*)lds;
    bf16_t* Vt = (bf16_t*)(lds + 55296);
    const float* kng = P->in[5] + l * 64; const float* qng = P->in[4] + l * 64;
#pragma unroll
    for (int j_ = 0; j_ < 6; ++j_) {
        const int item = tid + 512 * j_;
        const int i = item >> 3, ch = item & 7, kpos = pos0 - 128 + i;
        u32x4 raw = zero4;
        if (kpos >= 0 && kpos < L) raw = *(const u32x4*)(Pm + (size_t)(s0 + kpos) * NIN + 512 + g * 64 + ch * 8);
        float f[8]; unpack8(raw, f);
        float ss = 0.f;
#pragma unroll
        for (int j = 0; j < 8; ++j) ss += f[j] * f[j];
        ss += __shfl_xor(ss, 1); ss += __shfl_xor(ss, 2); ss += __shfl_xor(ss, 4);
        const float rs = rsqrtf(ss * (1.0f / 64.0f) + EPSV);
#pragma unroll
        for (int j = 0; j < 8; ++j) f[j] *= rs * kng[ch * 8 + j];
        *(u32x4*)(Kl + i * 72 + ch * 8) = pack8(f);
    }
#pragma unroll
    for (int j_ = 0; j_ < 6; ++j_) {
        const int item = tid + 512 * j_;
        const int ch = item / 384, i = item % 384, kpos = pos0 - 128 + i;
        u32x4 raw = zero4;
        if (kpos >= 0 && kpos < L) raw = *(const u32x4*)(Pm + (size_t)(s0 + kpos) * NIN + 640 + g * 64 + ch * 8);
        bf16_t* vp = Vt + (ch * 8) * 392 + i;
        vp[0] = (bf16_t)(raw.x & 0xffff); vp[392] = (bf16_t)(raw.x >> 16); vp[2 * 392] = (bf16_t)(raw.y & 0xffff); vp[3 * 392] = (bf16_t)(raw.y >> 16);
        vp[4 * 392] = (bf16_t)(raw.z & 0xffff); vp[5 * 392] = (bf16_t)(raw.z >> 16); vp[6 * 392] = (bf16_t)(raw.w & 0xffff); vp[7 * 392] = (bf16_t)(raw.w >> 16);
    }
    __syncthreads();
    const int w = __builtin_amdgcn_readfirstlane(tid >> 6), lane = tid & 63, r = lane & 31, h = lane >> 5;
    const int hq = g * 4 + (w >> 1), qoff = (w & 1) * 64;
    const float slope2 = exp2f(-(float)(hq + 1)) * LOG2E;
    const float sink2 = P->in[6][l * 8 + hq] * LOG2E;
    const float qscale = 0.125f * LOG2E;
    bf16x8 qf[2][4];
#pragma unroll
    for (int qg = 0; qg < 2; ++qg) {
        const int tok = tokq0 + qoff + qg * 32 + r;
        u32x4 raw[4]; float ss = 0.f;
#pragma unroll
        for (int c = 0; c < 4; ++c) { raw[c] = *(const u32x4*)(Pm + (size_t)tok * NIN + hq * 64 + 16 * c + 8 * h);
            float f[8]; unpack8(raw[c], f);
#pragma unroll
            for (int j = 0; j < 8; ++j) ss += f[j] * f[j]; }
        ss += __shfl_xor(ss, 32);
        const float rs = rsqrtf(ss * (1.0f / 64.0f) + EPSV) * qscale;
#pragma unroll
        for (int c = 0; c < 4; ++c) { float f[8]; unpack8(raw[c], f);
#pragma unroll
            for (int j = 0; j < 8; ++j) f[j] *= rs * qng[16 * c + 8 * h + j];
            qf[qg][c] = __builtin_bit_cast(bf16x8, pack8(f)); }
    }
    f32x16 o[2][2]; float rsum[2] = {0.f, 0.f};
#pragma unroll
    for (int a = 0; a < 2; ++a)
#pragma unroll
        for (int b = 0; b < 2; ++b)
#pragma unroll
            for (int i = 0; i < 16; ++i) o[a][b][i] = 0.f;
    const int kb_lo = qoff >> 5;
    for (int kb = kb_lo; kb < kb_lo + 10; ++kb) {
        const int i0 = kb * 32;
        bf16x8 kf[4];
#pragma unroll
        for (int c = 0; c < 4; ++c) kf[c] = *(const bf16x8*)(Kl + (i0 + r) * 72 + 16 * c + 8 * h);
        bf16x8 pf[2][2];
#pragma unroll
        for (int qg = 0; qg < 2; ++qg) {
            f32x16 s;
#pragma unroll
            for (int i = 0; i < 16; ++i) s[i] = 0.f;
#pragma unroll
            for (int c = 0; c < 4; ++c) s = __builtin_amdgcn_mfma_f32_32x32x16_bf16(kf[c], qf[qg][c], s, 0, 0, 0);
            const int qrel = qoff + qg * 32 + r + 128;
            float pv[16];
            const int rel = i0 - (qoff + qg * 32 + 128);
            const bool inseq = (pos0 - 128 + i0 >= 0) && (pos0 - 128 + i0 + 31 < L);
            if (rel < -128 || rel > 128) {
#pragma unroll
                for (int i = 0; i < 16; ++i) pv[i] = 0.f;
            } else if (inseq && rel != 0 && rel >= -96 && rel <= 96) {
                const float ssl = rel < 0 ? slope2 : -slope2;
                const float base = ssl * (float)(i0 + 4 * h - qrel);
#pragma unroll
                for (int i = 0; i < 16; ++i) {
                    const float e = __builtin_amdgcn_exp2f(s[i] + (base + ssl * (float)crow(i, 0)));
                    pv[i] = e; rsum[qg] += e;
                }
            } else {
#pragma unroll
                for (int i = 0; i < 16; ++i) {
                    const int ki = i0 + crow(i, h);
                    int dist = qrel - ki; dist = dist < 0 ? -dist : dist;
                    const int kpos = pos0 - 128 + ki;
                    const bool valid = (dist <= 128) && (kpos >= 0) && (kpos < L);
                    const float e = __builtin_amdgcn_exp2f(s[i] - slope2 * (float)dist);
                    pv[i] = valid ? e : 0.f;
                    rsum[qg] += pv[i];
                }
            }
#pragma unroll
            for (int sx = 0; sx < 2; ++sx) {
                u32x4 pw; pw.x = pk2(pv[8 * sx], pv[8 * sx + 1]); pw.y = pk2(pv[8 * sx + 2], pv[8 * sx + 3]); pw.z = pk2(pv[8 * sx + 4], pv[8 * sx + 5]); pw.w = pk2(pv[8 * sx + 6], pv[8 * sx + 7]);
                pf[qg][sx] = __builtin_bit_cast(bf16x8, pw);
            }
        }
#pragma unroll
        for (int dt = 0; dt < 2; ++dt)
#pragma unroll
            for (int sx = 0; sx < 2; ++sx) {
                const bf16_t* vb = Vt + (dt * 32 + r) * 392 + i0 + 16 * sx + 4 * h;
                const u32x2 lo = *(const u32x2*)vb, hi = *(const u32x2*)(vb + 8);
                u32x4 vv; vv.x = lo.x; vv.y = lo.y; vv.z = hi.x; vv.w = hi.y;
                const bf16x8 vf = __builtin_bit_cast(bf16x8, vv);
#pragma unroll
                for (int qg = 0; qg < 2; ++qg) o[qg][dt] = __builtin_amdgcn_mfma_f32_32x32x16_bf16(vf, pf[qg][sx], o[qg][dt], 0, 0, 0);
            }
    }
#pragma unroll
    for (int qg = 0; qg < 2; ++qg) {
        float lsum = rsum[qg] + __shfl_xor(rsum[qg], 32) + __builtin_amdgcn_exp2f(sink2);
        const float inv = 1.0f / lsum;
        const int tok = tokq0 + qoff + qg * 32 + r;
#pragma unroll
        for (int dt = 0; dt < 2; ++dt)
#pragma unroll
            for (int gq = 0; gq < 4; ++gq) {
                u32x2 ov; ov.x = pk2(o[qg][dt][4 * gq] * inv, o[qg][dt][4 * gq + 1] * inv); ov.y = pk2(o[qg][dt][4 * gq + 2] * inv, o[qg][dt][4 * gq + 3] * inv);
                *(u32x2*)(HB + (size_t)tok * DM + hq * 64 + dt * 32 + 8 * gq + 4 * h) = ov;
            }
    }
    __syncthreads();
}

DI void pool_unit(KP P, int l, int unit, unsigned char* lds, int tid_) {
    const int tid = opaque_v(tid_);
    const unsigned z0_ = (unsigned)opaque_v(0); const u32x4 zero4 = {z0_, z0_, z0_, z0_};
    const bf16_t* Pm = (const bf16_t*)(P->ws + WS_P);
    bf16_t* HB = (bf16_t*)(P->out);
    const int tok0 = unit * 64; int s0, L; seq_info(tok0, s0, L);
    const int pos0 = tok0 - s0;
    bf16_t* U = (bf16_t*)lds;
    bf16_t* DT = (bf16_t*)(lds + 40960);
#pragma unroll
    for (int j_ = 0; j_ < 5; ++j_) {
        const int item = tid + 512 * j_;
        const int rr = item >> 5, ch = item & 31, pos = pos0 - 8 + rr;
        u32x4 raw = zero4;
        if (pos >= 0 && pos < L) raw = *(const u32x4*)(Pm + (size_t)(s0 + pos) * NIN + 768 + ch * 8);
        *(u32x4*)(U + rr * 256 + ch * 8) = raw;
    }
    __syncthreads();
    const int c = tid & 255, th = tid >> 8, gi = c >> 6, hw = 1 << gi;
    {
        const int tfirst = th * 32;
        float sum = 0.f;
        for (int s = tfirst - hw; s < tfirst + hw; ++s) sum += bf2f(U[(s + 8) * 256 + c]);
        for (int tt = 0; tt < 32; ++tt) {
            const int t = tfirst + tt, pos = pos0 + t;
            const int lo = max(pos - hw, 0), hi = min(pos + hw, L);
            const float d = sum / (float)(hi - lo) - bf2f(U[(t + 8) * 256 + c]);
            DT[t * 264 + c] = f2bf(d);
            sum += bf2f(U[(t + hw + 8) * 256 + c]) - bf2f(U[(t - hw + 8) * 256 + c]);
        }
    }
    __syncthreads();
    {
        const int w = __builtin_amdgcn_readfirstlane(tid >> 6), lane = tid & 63, n = lane & 31, h = lane >> 5;
        const int g = w >> 1, nb = w & 1;
        const float* W = P->in[7] + (size_t)l * 4 * 64 * 64 + g * 4096 + 32 * nb + n;
        bf16x8 bw[4];
#pragma unroll
        for (int ks = 0; ks < 4; ++ks) {
            float wv[8];
#pragma unroll
            for (int j = 0; j < 8; ++j) wv[j] = W[(16 * ks + 8 * h + j) * 64];
            bw[ks] = __builtin_bit_cast(bf16x8, pack8(wv));
        }
        f32x16 acc[2];
#pragma unroll
        for (int mb = 0; mb < 2; ++mb) {
#pragma unroll
            for (int i = 0; i < 16; ++i) acc[mb][i] = 0.f;
#pragma unroll
            for (int ks = 0; ks < 4; ++ks) {
                const bf16x8 af = *(const bf16x8*)(DT + (32 * mb + n) * 264 + g * 64 + 16 * ks + 8 * h);
                acc[mb] = __builtin_amdgcn_mfma_f32_32x32x16_bf16(af, bw[ks], acc[mb], 0, 0, 0);
            }
        }
        const int oc = g * 64 + 32 * nb + n;
        const float sc = P->in[8][l * 256 + oc];
#pragma unroll
        for (int mb = 0; mb < 2; ++mb)
#pragma unroll
            for (int i = 0; i < 16; ++i) HB[(size_t)(tok0 + 32 * mb + crow(i, h)) * DM + 512 + oc] = f2bf(acc[mb][i] * sc);
    }
    __syncthreads();
}

DI void prep_unit(KP P, int l, int unit, unsigned char* lds, int tid_) {
    const int tid = opaque_v(tid_);
    const unsigned z0_ = (unsigned)opaque_v(0); const u32x4 zero4 = {z0_, z0_, z0_, z0_};
    const bf16_t* Pm = (const bf16_t*)(P->ws + WS_P);
    bf16_t* HY = (bf16_t*)(P->ws + WS_HY);
    const int tok0 = unit * 64; int s0, L; seq_info(tok0, s0, L);
    const int pos0 = tok0 - s0;
    unsigned* Tw = (unsigned*)lds;
    const float* cw = P->in[9] + (size_t)l * 3 * 768; const float* cb = P->in[10] + l * 768;
    if (tid < 480) {
        const int ch = tid % 96, tg = tid / 96, col = ch * 8, tfirst = 13 * tg;
        const f32x4 w0a = *(const f32x4*)(cw + col), w0b = *(const f32x4*)(cw + col + 4), w1a = *(const f32x4*)(cw + 768 + col), w1b = *(const f32x4*)(cw + 768 + col + 4);
        const f32x4 w2a = *(const f32x4*)(cw + 1536 + col), w2b = *(const f32x4*)(cw + 1536 + col + 4), bba = *(const f32x4*)(cb + col), bbb = *(const f32x4*)(cb + col + 4);
        u32x4 rows[15];
#pragma unroll
        for (int r = 0; r < 15; ++r) {
            const int t = tfirst - 1 + r, pos = pos0 + t;
            rows[r] = zero4;
            if (t <= 64 && pos >= 0 && pos < L) rows[r] = *(const u32x4*)(Pm + (size_t)(s0 + pos) * NIN + 1024 + col);
        }
#pragma unroll
        for (int i = 0; i < 13; ++i) {
            const int t = tfirst + i;
            if (t < 64) {
                float fa[8], fb[8], fd[8]; unpack8(rows[i], fa); unpack8(rows[i + 1], fb); unpack8(rows[i + 2], fd);
                bf16_t* Tb = (bf16_t*)(Tw + (((t >> 1) + ch) & 31)) + (t & 1);
#pragma unroll
                for (int j = 0; j < 8; ++j) {
                    const float w0 = j < 4 ? w0a[j & 3] : w0b[j & 3], w1 = j < 4 ? w1a[j & 3] : w1b[j & 3], w2 = j < 4 ? w2a[j & 3] : w2b[j & 3], bb = j < 4 ? bba[j & 3] : bbb[j & 3];
                    const float v = fa[j] * w0 + fb[j] * w1 + fd[j] * w2 + bb;
                    Tb[(col + j) * 66] = f2bf(v);
                }
            }
        }
    }
    __syncthreads();
#pragma unroll 4
    for (int j_ = 0; j_ < 12; ++j_) {
        const int item = tid + 512 * j_;
        const int cc = item >> 3, q = item & 7, rot = cc >> 3;
        const unsigned* rowp = Tw + cc * 33;
        u32x4 v; v.x = rowp[(4 * q + rot) & 31]; v.y = rowp[(4 * q + 1 + rot) & 31]; v.z = rowp[(4 * q + 2 + rot) & 31]; v.w = rowp[(4 * q + 3 + rot) & 31];
        const int arr = cc >> 8, ch = cc & 255;
        *(u32x4*)(HY + (size_t)arr * HY_ARR + (size_t)ch * NT + tok0 + q * 8) = v;
    }
    __syncthreads();
}

template <bool SAMPLE>
DI void hyena_unit(const bf16_t* Uin, const bf16_t* Gate, bf16_t* Zout, const bf16_t* kr, int c, unsigned char* lds, int tid_) {
    const int tid = opaque_v(tid_);
    constexpr int NB = SAMPLE ? 128 : 32;
    constexpr int L = NB * 128;
    constexpr int KRL = 2 * L + 512;
    constexpr int SEQ_STRIDE = 8768;
    constexpr int ZERO_OFF = SAMPLE ? 128 * 272 : 8 * SEQ_STRIDE;
    constexpr int KR_OFF = SAMPLE ? 35328 : 70656;
    const int w = __builtin_amdgcn_readfirstlane(tid >> 6), lane = tid & 63, n = lane & 31, h = lane >> 5;
    {
        constexpr int NU = SAMPLE ? 4 : 8;
        constexpr int NK = (KRL / 8 + 511) / 512;
        u32x4 uv[NU], kv[NK];
#pragma unroll
        for (int j = 0; j < NU; ++j) uv[j] = *(const u32x4*)(Uin + (size_t)c * NT + (SAMPLE ? NTP : 0) + (tid + 512 * j) * 8);
#pragma unroll
        for (int j = 0; j < NK; ++j) { const int item = tid + 512 * j; kv[j] = *(const u32x4*)(kr + (item < KRL / 8 ? item : 0) * 8); }
#pragma unroll
        for (int j = 0; j < NU; ++j) {
            const int t8 = (tid + 512 * j) * 8;
            if (SAMPLE) { const int a = t8 >> 7, wi = t8 & 127; *(u32x4*)(lds + a * 272 + wi * 2) = uv[j]; }
            else { const int b = t8 >> 12, tt = t8 & 4095, a = tt >> 7, wi = tt & 127; *(u32x4*)(lds + b * SEQ_STRIDE + a * 272 + wi * 2) = uv[j]; }
        }
#pragma unroll
        for (int j = 0; j < NK; ++j) { const int item = tid + 512 * j; if (item < KRL / 8) *(u32x4*)(lds + KR_OFF + item * 16) = kv[j]; }
    }
    if (tid < 17) { const unsigned z0_ = (unsigned)opaque_v(0); *(u32x4*)(lds + ZERO_OFF + tid * 16) = (u32x4){z0_, z0_, z0_, z0_}; }
    __syncthreads();
    if (!SAMPLE) {
        constexpr int NCH = KRL / 8;
        for (int task = tid; task < 3 * NCH; task += 512) {
            const int e = task / NCH + 1, ch = task % NCH;
            const unsigned* src = (const unsigned*)(lds + KR_OFF) + ch * 4;
            const u32x4 d03 = *(const u32x4*)src; const unsigned d4 = src[4], d5 = src[5];
            const bool k1 = (e >> 1) != 0; const unsigned shb = (unsigned)(e & 1) * 16u;
            const unsigned e0 = k1 ? d03.y : d03.x, e1 = k1 ? d03.z : d03.y, e2 = k1 ? d03.w : d03.z, e3 = k1 ? d4 : d03.w, e4 = k1 ? d5 : d4;
            u32x4 o; o.x = __builtin_amdgcn_alignbit(e1, e0, shb); o.y = __builtin_amdgcn_alignbit(e2, e1, shb); o.z = __builtin_amdgcn_alignbit(e3, e2, shb); o.w = __builtin_amdgcn_alignbit(e4, e3, shb);
            *(u32x4*)(lds + KR_OFF + e * (KRL * 2) + ch * 16) = o;
        }
        __syncthreads();
    }
    const int a_n = SAMPLE ? 32 * (w & 3) + n : 4 * w + (n & 3);
    const int b_n = SAMPLE ? 0 : (n >> 2);
    const unsigned char* ubase = lds + b_n * SEQ_STRIDE;
    const int dlo = SAMPLE ? 32 * (w & 3) - 127 : 4 * w - 31;
    const int dhi = SAMPLE ? 32 * (w & 3) + 31 : 4 * w + 3;
    const int idxc = 8 * h - n + L + KR_PAD;
    const int esh = (4 - (n & 3)) & 3;
    const bool ek = (esh >> 1) != 0;
    const unsigned sh = (unsigned)(esh & 1) * 16u;
    const unsigned char* lb = lds + KR_OFF + (SAMPLE ? 0 : esh * (KRL * 2)) + (idxc - esh) * 2 - 6 * 32;
    f32x16 acc[4];
#pragma unroll
    for (int r = 0; r < 4; ++r)
#pragma unroll
        for (int i = 0; i < 16; ++i) acc[r][i] = 0.f;
    const int dfirst = SAMPLE ? ((w >> 2) ? dlo + 80 : dlo) : dlo;
    const int dlast = SAMPLE ? ((w >> 2) ? dhi : dlo + 79) : dhi;
    bf16x8 afr[24];
#define HY_FRAG(dst, ab, d) do { const u32x2* p_ = (const u32x2*)((ab) + (d) * 32); \
        if (SAMPLE) { const u32x2 x0 = p_[0], x1 = p_[1], x2 = p_[2]; \
            const unsigned e0 = ek ? x0.y : x0.x, e1 = ek ? x1.x : x0.y, e2 = ek ? x1.y : x1.x, e3 = ek ? x2.x : x1.y, e4 = ek ? x2.y : x2.x; \
            u32x4 o_; o_.x = __builtin_amdgcn_alignbit(e1, e0, sh); o_.y = __builtin_amdgcn_alignbit(e2, e1, sh); o_.z = __builtin_amdgcn_alignbit(e3, e2, sh); o_.w = __builtin_amdgcn_alignbit(e4, e3, sh); \
            dst = __builtin_bit_cast(bf16x8, o_); } \
        else { const u32x2 x0 = p_[0], x1 = p_[1]; u32x4 o_; o_.x = x0.x; o_.y = x0.y; o_.z = x1.x; o_.w = x1.y; dst = __builtin_bit_cast(bf16x8, o_); } } while (0)
#define HY_MMA(SO) do { const int blk = a_n - delta; const bool valid = (blk >= 0) && (blk < NB); \
        const unsigned char* bp = valid ? ubase + blk * 272 + 16 * h : lds + ZERO_OFF + 16 * h; const int qs = valid ? 32 : 0; \
        bf16x8 bfr[8]; \
        _Pragma("unroll") for (int q = 0; q < 8; ++q) bfr[q] = *(const bf16x8*)(bp + qs * q); \
        __builtin_amdgcn_s_setprio(1); \
        _Pragma("unroll") for (int q = 0; q < 8; ++q) _Pragma("unroll") for (int r = 0; r < 4; ++r) \
            acc[r] = __builtin_amdgcn_mfma_f32_32x32x16_bf16(afr[(q - 2 * r + 6 + (SO)) % 24], bfr[q], acc[r], 0, 0, 0); \
        __builtin_amdgcn_s_setprio(0); } while (0)
#define HY_NEXT(NBASE) do { const unsigned char* ab_ = lb - (delta + 1) * 256; \
        _Pragma("unroll") for (int d = 0; d < 8; ++d) HY_FRAG(afr[(NBASE) + d], ab_, d); } while (0)
    {
        const unsigned char* ab = lb - dfirst * 256;
#pragma unroll
        for (int d = 0; d < 14; ++d) HY_FRAG(afr[d], ab, d);
    }
    for (int delta = dfirst;;) {
        HY_MMA(0); HY_NEXT(16);
        if (++delta > dlast) break;
        HY_MMA(16); HY_NEXT(8);
        if (++delta > dlast) break;
        HY_MMA(8); HY_NEXT(0);
        if (++delta > dlast) break;
    }
#undef HY_NEXT
#undef HY_MMA
#undef HY_FRAG
    if (SAMPLE) {
        __syncthreads();
        float* RED = (float*)(lds + KR_OFF);
        if (w >= 4) {
#pragma unroll
            for (int r = 0; r < 4; ++r)
#pragma unroll
                for (int i = 0; i < 16; ++i) RED[((w & 3) * 64 + r * 16 + i) * 64 + lane] = acc[r][i];
        }
        __syncthreads();
        if (w < 4) {
#pragma unroll
            for (int r = 0; r < 4; ++r)
#pragma unroll
                for (int i = 0; i < 16; ++i) acc[r][i] += RED[(w * 64 + r * 16 + i) * 64 + lane];
        }
    }
    if (!SAMPLE || w < 4) {
        const size_t tb = (size_t)c * NT + (SAMPLE ? NTP + a_n * 128 : b_n * 4096 + a_n * 128);
#pragma unroll
        for (int r = 0; r < 4; ++r)
#pragma unroll
            for (int gq = 0; gq < 4; ++gq) {
                const size_t idx = tb + 32 * r + 8 * gq + 4 * h;
                const u32x2 gv = *(const u32x2*)(Gate + idx);
                u32x2 ov; ov.x = pk2(acc[r][4 * gq] * bflo(gv.x), acc[r][4 * gq + 1] * bfhi(gv.x)); ov.y = pk2(acc[r][4 * gq + 2] * bflo(gv.y), acc[r][4 * gq + 3] * bfhi(gv.y));
                *(u32x2*)(Zout + idx) = ov;
            }
    }
    __syncthreads();
}

DI void fin_unit(KP P, int l, int unit, unsigned char* lds, int tid_) {
    const int tid = opaque_v(tid_);
    bf16_t* HB = (bf16_t*)(P->out);
    const bf16_t* Z2 = (const bf16_t*)(P->ws + WS_HY);
    const float* og = P->in[19] + l * 1024;
    const int tok0 = unit * 64;
    float* T = (float*)lds;
    const int w = tid >> 6, lane = tid & 63;
    u32x4 ra[8]; u32x2 rb[8];
#pragma unroll
    for (int rr = 0; rr < 8; ++rr) { const bf16_t* row = HB + (size_t)(tok0 + w * 8 + rr) * DM; ra[rr] = *(const u32x4*)(row + lane * 8); rb[rr] = *(const u32x2*)(row + 512 + lane * 4); }
    const f32x4 ga0 = *(const f32x4*)(og + lane * 8), ga1 = *(const f32x4*)(og + lane * 8 + 4), gb = *(const f32x4*)(og + 512 + lane * 4), gc = *(const f32x4*)(og + 768 + lane * 4);
    u32x4 zv[4];
#pragma unroll
    for (int j_ = 0; j_ < 4; ++j_) { const int item = tid + 512 * j_; zv[j_] = *(const u32x4*)(Z2 + (size_t)(item >> 3) * NT + tok0 + (item & 7) * 8); }
#pragma unroll
    for (int j_ = 0; j_ < 4; ++j_) {
        const int item = tid + 512 * j_;
        const int cc = item >> 3, q = item & 7;
        float f[8]; unpack8(zv[j_], f);
#pragma unroll
        for (int j = 0; j < 8; ++j) T[(q * 8 + j) * 257 + cc] = f[j];
    }
    __syncthreads();
#pragma unroll
    for (int rr = 0; rr < 8; ++rr) {
        const int t = w * 8 + rr; bf16_t* row = HB + (size_t)(tok0 + t) * DM;
        {
            float f[8]; unpack8(ra[rr], f); float ss = 0.f;
#pragma unroll
            for (int j = 0; j < 8; ++j) ss += f[j] * f[j];
            ss = wave_sum(ss); const float rs = __builtin_amdgcn_rsqf(ss * (1.0f / 512.0f) + EPSV);
#pragma unroll
            for (int j = 0; j < 4; ++j) { f[j] *= rs * ga0[j]; f[4 + j] *= rs * ga1[j]; }
            *(u32x4*)(row + lane * 8) = pack8(f);
        }
        {
            const u32x2 raw = rb[rr];
            float f0 = bflo(raw.x), f1 = bfhi(raw.x), f2 = bflo(raw.y), f3 = bfhi(raw.y);
            float ss = wave_sum(f0 * f0 + f1 * f1 + f2 * f2 + f3 * f3); const float rs = __builtin_amdgcn_rsqf(ss * (1.0f / 256.0f) + EPSV);
            u32x2 ov; ov.x = pk2(f0 * rs * gb[0], f1 * rs * gb[1]); ov.y = pk2(f2 * rs * gb[2], f3 * rs * gb[3]);
            *(u32x2*)(row + 512 + lane * 4) = ov;
        }
        {
            const float* tp = T + t * 257 + lane * 4;
            const float f0 = tp[0], f1 = tp[1], f2 = tp[2], f3 = tp[3];
            float ss = wave_sum(f0 * f0 + f1 * f1 + f2 * f2 + f3 * f3); const float rs = __builtin_amdgcn_rsqf(ss * (1.0f / 256.0f) + EPSV);
            u32x2 ov; ov.x = pk2(f0 * rs * gc[0], f1 * rs * gc[1]); ov.y = pk2(f2 * rs * gc[2], f3 * rs * gc[3]);
            *(u32x2*)(row + 768 + lane * 4) = ov;
        }
    }
    __syncthreads();
}

__global__ void __launch_bounds__(512, 2) mega(Params Parg) {
    extern __shared__ __attribute__((aligned(16))) unsigned char lds[];
    cg::grid_group grid = cg::this_grid();
    LAS unsigned char* ldsl = (LAS unsigned char*)lds;
    const int tid = threadIdx.x;
    KP Pk = (KP)__builtin_amdgcn_kernarg_segment_ptr();
#define PH_BEGIN() KP P = Pk; asm volatile("" : "+s"(P)); const int bid = opaque_s(blockIdx.x), G = opaque_s(gridDim.x); unsigned char* ws = P->ws; (void)ws; (void)bid; (void)G
    volatile LAS unsigned* stw = (volatile LAS unsigned*)(ldsl + LDS_BYTES - 16);
    if (tid < 4) stw[tid] = 0u;
    __syncthreads();
    const XcdBarrier xb = xcd_barrier_post((unsigned*)(Pk->ws + WS_BAR), stw);
#define GSYNC() xcd_barrier(xb)

    if constexpr ((PHM & 1) != 0) for (int rep = 0; rep < REP_P0; ++rep) {
        PH_BEGIN();
        for (int u = bid; u < 2 * 2816 / 4; u += G) transpose_group(P, ws, u, lds, tid);
        for (int u = bid; u < 2 * 320; u += G) {
            const int l = u / 320, t = u % 320;
            if (t < 256) filter_tile(P, l, 0, t, lds, tid); else filter_tile(P, l, 1, t - 256, lds, tid);
        }
        for (int idx = bid * 512 + tid; idx < 2048 * 513; idx += G * 512) {
            const int arr = idx / 513, j = idx % 513;
            const int kind = arr >> 10, a = arr & 1023;
            const int Lx = kind ? 4096 : 16384, KRL = kind ? KRP_LEN : KRS_LEN;
            bf16_t* base = (bf16_t*)(ws + (kind ? WS_KRP : WS_KRS)) + (size_t)a * KRL;
            base[j <= 256 ? j : 2 * Lx + j - 1] = 0;
        }
        xb_rows(P->in[0], P->in[1], (bf16_t*)(ws + WS_HB), (float*)(ws + WS_SS), tid, bid, G);
    }
    if (Pk->ws == nullptr) grid.sync();
    GSYNC();

    for (int l = 0; l < 2; ++l) {
        if constexpr ((PHM & 2) != 0) {
            PH_BEGIN();
            pg8::Gemm g{(const bf16_t*)(ws + WS_HB), (const bf16_t*)(ws + WS_WIN) + (size_t)l * 1792 * 1024, 1024};
            pg8::StaticOrder S; S.init(NT, NIN, G, bid);
            pg8::EpiBf16 E{(bf16_t*)(ws + WS_P), NIN, (const float*)(ws + WS_SS) + (size_t)(l == 0 ? 0 : 2) * NT};
            for (int rep = 0; rep < REP_L1; ++rep) pg8::gemm_phase<pg8::EpiBf16, pg8::StaticOrder, true, 1024>(ldsl, g, S, E);
        }
        GSYNC();
        {
            PH_BEGIN();
            for (int rep = 0; rep < REP_L2; ++rep)
            for (int u = bid; u < 3 * 768; u += G) {
                if (u < 768) { if constexpr ((PHM & 4) != 0) attn_unit(P, l, u, lds, tid); }
                else if (u < 1536) { if constexpr ((PHM & 8) != 0) pool_unit(P, l, u - 768, lds, tid); }
                else { if constexpr ((PHM & 16) != 0) prep_unit(P, l, u - 1536, lds, tid); }
            }
        }
        GSYNC();
        for (int o = 0; o < 2; ++o) {
            {
                PH_BEGIN();
                bf16_t* HY = (bf16_t*)(ws + WS_HY);
                const bf16_t* Uin = o == 0 ? HY : HY + 3 * HY_ARR;
                const bf16_t* Gt = HY + (size_t)(1 + o) * HY_ARR;
                bf16_t* Zo = o == 0 ? HY + 3 * HY_ARR : HY;
                for (int rep = 0; rep < REP_HY; ++rep)
                for (int u = bid; u < 512; u += G) {
                    const int c = u & 255;
                    if constexpr ((PHM & 32) != 0) { if (u < 256) hyena_unit<true>(Uin, Gt, Zo, (const bf16_t*)(ws + WS_KRS) + (size_t)((l * 2 + o) * 256 + c) * KRS_LEN, c, lds, tid);
                    else hyena_unit<false>(Uin, Gt, Zo, (const bf16_t*)(ws + WS_KRP) + (size_t)((l * 2 + o) * 256 + c) * KRP_LEN, c, lds, tid); }
                }
            }
            if (o == 0 && gridDim.x == 256) {
                asm volatile("s_waitcnt vmcnt(0)" ::: "memory");
                __syncthreads();
                __builtin_amdgcn_fence(__ATOMIC_ACQUIRE, "agent");
                asm volatile("s_waitcnt vmcnt(0)" ::: "memory");
            } else GSYNC();
        }
        if constexpr ((PHM & 64) != 0) { PH_BEGIN(); for (int u = bid; u < 768; u += G) fin_unit(P, l, u, lds, tid); }
        GSYNC();
        if constexpr ((PHM & 128) != 0) {
            PH_BEGIN();
            pg8::Gemm g{(const bf16_t*)(P->out), (const bf16_t*)(ws + WS_WOUT) + (size_t)l * 1024 * 1024, 1024};
            pg8::StaticOrder S; S.init(NT, DM, G, bid);
            pg8::EpiResid<false> E{(bf16_t*)(ws + WS_HB), (float*)(ws + WS_SS) + (size_t)(l == 0 ? 1 : 3) * NT, nullptr};
            pg8::gemm_phase<pg8::EpiResid<false>, pg8::StaticOrder, true, 1024>(ldsl, g, S, E);
        }
        GSYNC();
        if constexpr ((PHM & 256) != 0) {
            PH_BEGIN();
            pg8::Gemm g{(const bf16_t*)(ws + WS_HB), (const bf16_t*)(ws + WS_WF1) + (size_t)l * 5632 * 1024, 1024};
            pg8::FfnOrder S; S.G = G; S.vb = (G % 8 == 0) ? (bid % 8) * (G / 8) + bid / 8 : bid;
            pg8::EpiFfnReg E{(bf16_t*)(ws + WS_ACT), P->in[23] + (size_t)l * 3 * NFF2, P->in[24] + (size_t)l * NFF2, (const float*)(ws + WS_SS) + (size_t)(l == 0 ? 1 : 3) * NT};
            for (int rep = 0; rep < REP_FFN; ++rep) pg8::gemm_phase<pg8::EpiFfnReg, pg8::FfnOrder, true, 1024, 62>(ldsl, g, S, E);
        }
        GSYNC();
        if constexpr ((PHM & 512) != 0) {
            PH_BEGIN();
            pg8::Gemm g{(const bf16_t*)(ws + WS_ACT), (const bf16_t*)(ws + WS_WF2) + (size_t)l * 1024 * 2816, 2816};
            pg8::StaticOrder S; S.init(NT, DM, G, bid);
            if (l == 0) {
                pg8::EpiResid<false> E{(bf16_t*)(ws + WS_HB), (float*)(ws + WS_SS) + (size_t)2 * NT, nullptr};
                pg8::gemm_phase<pg8::EpiResid<false>, pg8::StaticOrder, true, 2816>(ldsl, g, S, E);
            } else {
                pg8::EpiResid<true> E{(bf16_t*)(ws + WS_HB), nullptr, P->out};
                pg8::gemm_phase<pg8::EpiResid<true>, pg8::StaticOrder, true, 2816>(ldsl, g, S, E);
            }
        }
        if (l == 0) GSYNC();
    }
}

extern "C" void kernel_launch(void* const* d_in, const int* in_sizes, int n_in, void* d_out, int out_size, void* d_ws, size_t ws_size, hipStream_t stream) {
    static int grid = 0;
    if (grid == 0) {
        if (n_in != 26 || ws_size < WS_END) { fprintf(stderr, "kernel_launch: need 26 inputs and %zu bytes of workspace (got %d, %zu)\n", (size_t)WS_END, n_in, ws_size); grid = -1; return; }
        int dev = 0, cus = 0, per_cu = 0;
        hipGetDevice(&dev);
        hipDeviceGetAttribute(&cus, hipDeviceAttributeMultiprocessorCount, dev);
        if (hipFuncSetAttribute((const void*)mega, hipFuncAttributeMaxDynamicSharedMemorySize, LDS_BYTES) != hipSuccess) { fprintf(stderr, "kernel_launch: hipFuncSetAttribute failed\n"); grid = -1; return; }
        hipOccupancyMaxActiveBlocksPerMultiprocessor(&per_cu, (const void*)mega, 512, LDS_BYTES);
        if (per_cu < 1) { fprintf(stderr, "kernel_launch: occupancy query says %d blocks per CU\n", per_cu); per_cu = 1; }
        (void)hipGetLastError();
        grid = cus * 1;
    }
    if (grid < 0) return;
    Params p{};
    for (int i = 0; i < 26; ++i) p.in[i] = (const float*)d_in[i];
    p.out = (float*)d_out; p.ws = (unsigned char*)d_ws;
    if (hipMemsetAsync((char*)d_ws + WS_BAR, 0, 16384, stream) != hipSuccess) { fprintf(stderr, "memset failed\n"); return; }
    void* args[] = {&p};
    hipError_t e = hipLaunchCooperativeKernel((const void*)mega, dim3(grid), dim3(512), args, LDS_BYTES, stream);
    if (e != hipSuccess) fprintf(stderr, "cooperative launch failed: %s (grid %d)\n", hipGetErrorString(e), grid);
}
```
